# Optimizing an MI355X kernel written in HIP

```python
import math
import jax, jax.numpy as jnp
from jax import lax
import numpy as np

D_MODEL = 1024
BATCH = 4
SEQ = 4096
DEPTH = 2

CTX_LEN = 256
GRID_W = 64
HEAD_DIM = 64
A_GROUPS = 4
A_WIDTH = A_GROUPS * HEAD_DIM
MLP_CHUNK = 128
ATT_Q_HEADS = 6
ATT_KV_HEADS = 2
ATT_GROUP = ATT_Q_HEADS // ATT_KV_HEADS
ATT_WIDTH = ATT_Q_HEADS * HEAD_DIM
KV_WIDTH = ATT_KV_HEADS * HEAD_DIM
Q_BLOCK = 128
ROPE_THETA = 10000.0
DN_HEADS = 6
DN_WIDTH = DN_HEADS * HEAD_DIM
DN_CONV = 5
DN_CHUNK = 64
MIX_WIDTH = A_WIDTH + ATT_WIDTH + DN_WIDTH
A_COLS = 2 * A_WIDTH
B_COLS = ATT_WIDTH + 2 * KV_WIDTH
C_COLS = 4 * DN_WIDTH + 4 * DN_HEADS
IN_COLS = A_COLS + B_COLS + C_COLS
D_FF = 4 * D_MODEL
DEEPNORM_ALPHA = (2 * DEPTH) ** 0.25
DEEPNORM_BETA = (8 * DEPTH) ** -0.25
EPS = 1e-6

kernel_name = "hybrid_gmlp_gqa_deltanet_dit_block"


def _norm(x):
    xf = x.astype(jnp.float32)
    mu = jnp.mean(xf, -1, keepdims=True)
    var = jnp.mean(jnp.square(xf - mu), -1, keepdims=True)
    return ((xf - mu) * lax.rsqrt(var + EPS)).astype(x.dtype)


def layer_norm(x, g, b):
    return _norm(x) * g + b


def rms_norm(x, g):
    xf = x.astype(jnp.float32)
    return (xf * lax.rsqrt(jnp.mean(xf * xf, -1, keepdims=True) + EPS)).astype(x.dtype) * g


def l2_normalize(x):
    xf = x.astype(jnp.float32)
    return (xf * lax.rsqrt(jnp.sum(xf * xf, -1, keepdims=True) + EPS)).astype(x.dtype)


def modulate(x, shift, scale):
    return _norm(x) * (1.0 + scale) + shift


def axial_rope_angles(rows):
    row = jnp.repeat(jnp.arange(rows, dtype=jnp.float32), GRID_W)
    col = jnp.tile(jnp.arange(GRID_W, dtype=jnp.float32), rows)
    half = HEAD_DIM // 2
    inv = 1.0 / (ROPE_THETA ** (jnp.arange(0, half, 2, dtype=jnp.float32) / half))
    return row[:, None] * inv, col[:, None] * inv


def _rotate(x, ang):
    cos = jnp.cos(ang)[None, :, None, :].astype(x.dtype)
    sin = jnp.sin(ang)[None, :, None, :].astype(x.dtype)
    x1, x2 = jnp.split(x, 2, -1)
    return jnp.concatenate([x1 * cos - x2 * sin, x2 * cos + x1 * sin], -1)


def apply_axial_rope(x, ang_row, ang_col):
    xr, xc = jnp.split(x, 2, -1)
    return jnp.concatenate([_rotate(xr, ang_row), _rotate(xc, ang_col)], -1)


def chunk_token_mlp(p, ln_g, ln_b, w_s, b_s):
    bsz, n, _ = p.shape
    u, v = jnp.split(jax.nn.gelu(p, approximate=False), 2, -1)
    v = layer_norm(v, ln_g, ln_b).reshape(bsz, n // MLP_CHUNK, MLP_CHUNK, A_GROUPS, HEAD_DIM)
    mixed = jnp.einsum('bcsgd,gts->bctgd', v, w_s) + b_s.T[None, None, :, :, None]
    return u * mixed.reshape(bsz, n, A_WIDTH)


def _attend(q, k, v):
    s = jnp.einsum('bqhgd,bkhd->bhgqk', q, k).astype(jnp.float32) * (HEAD_DIM ** -0.5)
    pr = jax.nn.softmax(s, axis=-1).astype(v.dtype)
    return jnp.einsum('bhgqk,bkhd->bqhgd', pr, v)


def gqa_mixer(p_ctx, p_lat, q_g, k_g, ang_row, ang_col, need_ctx):
    def split(p):
        bsz, n, _ = p.shape
        q = p[..., :ATT_WIDTH].reshape(bsz, n, ATT_Q_HEADS, HEAD_DIM)
        k = p[..., ATT_WIDTH:ATT_WIDTH + KV_WIDTH].reshape(bsz, n, ATT_KV_HEADS, HEAD_DIM)
        v = p[..., ATT_WIDTH + KV_WIDTH:].reshape(bsz, n, ATT_KV_HEADS, HEAD_DIM)
        return rms_norm(q, q_g), rms_norm(k, k_g), v

    qc, kc, vc = split(p_ctx)
    ql, kl, vl = split(p_lat)
    ql = apply_axial_rope(ql, ang_row, ang_col)
    kl = apply_axial_rope(kl, ang_row, ang_col)
    bsz, n = p_lat.shape[:2]
    k_all = jnp.concatenate([kl, kc], 1)
    v_all = jnp.concatenate([vl, vc], 1)
    qb = ql.reshape(bsz, n // Q_BLOCK, Q_BLOCK, ATT_KV_HEADS, ATT_GROUP, HEAD_DIM).transpose(1, 0, 2, 3, 4, 5)
    ol = lax.map(lambda qblk: _attend(qblk, k_all, v_all), qb)
    ol = ol.transpose(1, 0, 2, 3, 4, 5).reshape(bsz, n, ATT_WIDTH)
    oc = None
    if need_ctx:
        nc = p_ctx.shape[1]
        oc = _attend(qc.reshape(bsz, nc, ATT_KV_HEADS, ATT_GROUP, HEAD_DIM), kc, vc).reshape(bsz, nc, ATT_WIDTH)
    return oc, ol


def short_conv(x, w):
    out = lax.conv_general_dilated(x, w[:, None, :], window_strides=(1,),
                                   padding=[(DN_CONV // 2, DN_CONV // 2)],
                                   dimension_numbers=('NWC', 'WIO', 'NWC'),
                                   feature_group_count=x.shape[-1])
    return jax.nn.silu(out)


def gated_delta_rule(q, k, v, g, beta, state):
    bsz, n, h, d = q.shape
    nc = n // DN_CHUNK

    def chunks(t):
        t = jnp.moveaxis(t.astype(jnp.float32), 2, 1)
        return t.reshape(bsz, h, nc, DN_CHUNK, *t.shape[3:])

    qf, kf, vf = chunks(q), chunks(k), chunks(v)
    gc = jnp.cumsum(chunks(g), -1)
    bf = chunks(beta)
    incl = jnp.tril(jnp.ones((DN_CHUNK, DN_CHUNK), bool))
    strict = jnp.tril(jnp.ones((DN_CHUNK, DN_CHUNK), bool), -1)
    diff = gc[..., :, None] - gc[..., None, :]
    decay = jnp.where(incl, jnp.exp(jnp.minimum(diff, 0.0)), 0.0)
    kb = kf * bf[..., None]
    lower = jnp.where(strict, jnp.einsum('bhcid,bhcjd->bhcij', kb, kf) * decay, 0.0)
    eye = jnp.eye(DN_CHUNK, dtype=jnp.float32)
    rhs = jnp.concatenate([vf * bf[..., None], kb * jnp.exp(gc)[..., None]], -1)
    sol = lax.linalg.triangular_solve(eye + lower, rhs, left_side=True, lower=True, unit_diagonal=True)
    u, w = jnp.split(sol, 2, -1)
    intra = jnp.where(incl, jnp.einsum('bhcid,bhcjd->bhcij', qf, kf) * decay, 0.0)
    g_last = gc[..., -1]
    q_dec = qf * jnp.exp(gc)[..., None]
    k_dec = kf * jnp.exp(g_last[..., None] - gc)[..., None]
    xs = tuple(jnp.moveaxis(t, 2, 0) for t in (q_dec, k_dec, u, w, intra, g_last))

    def step(s, inp):
        qd, kd, u_i, w_i, a_i, gl = inp
        v_new = u_i - jnp.einsum('bhck,bhkv->bhcv', w_i, s)
        o = jnp.einsum('bhck,bhkv->bhcv', qd, s) + jnp.einsum('bhij,bhjv->bhiv', a_i, v_new)
        s = s * jnp.exp(gl)[..., None, None] + jnp.einsum('bhck,bhcv->bhkv', kd, v_new)
        return s, o

    s_final, o = lax.scan(step, state, xs)
    o = jnp.moveaxis(o, 0, 2).reshape(bsz, h, n, d)
    return jnp.moveaxis(o, 1, 2).astype(v.dtype), s_final


def deltanet_mixer(p_ctx, p_lat, conv_w, a_log, dt_bias, norm_g, need_ctx):
    def prep(p):
        bsz, n, _ = p.shape
        qkv = short_conv(p[..., :3 * DN_WIDTH], conv_w)
        q, k, v = jnp.split(qkv, 3, -1)
        q = l2_normalize(q.reshape(bsz, n, DN_HEADS, HEAD_DIM)) * (HEAD_DIM ** -0.5)
        k = l2_normalize(k.reshape(bsz, n, DN_HEADS, HEAD_DIM))
        v = v.reshape(bsz, n, DN_HEADS, HEAD_DIM)
        z = p[..., 3 * DN_WIDTH:4 * DN_WIDTH]
        a = p[..., 4 * DN_WIDTH:4 * DN_WIDTH + 2 * DN_HEADS].reshape(bsz, n, 2, DN_HEADS).astype(jnp.float32)
        bt = p[..., 4 * DN_WIDTH + 2 * DN_HEADS:].reshape(bsz, n, 2, DN_HEADS).astype(jnp.float32)
        g = -jnp.exp(a_log.astype(jnp.float32)) * jax.nn.softplus(a + dt_bias.astype(jnp.float32))
        return q, k, v, z, g, jax.nn.sigmoid(bt)

    def out_gate(o, z):
        bsz, n = z.shape[:2]
        zz = z.reshape(bsz, n, DN_HEADS, HEAD_DIM)
        return (rms_norm(o, norm_g) * jax.nn.silu(zz)).reshape(bsz, n, DN_WIDTH)

    flip = lambda t: jnp.flip(t, 1)
    qc, kc, vc, zc, gc, bc = prep(p_ctx)
    ql, kl, vl, zl, gl, bl = prep(p_lat)
    bsz = p_lat.shape[0]
    zero = jnp.zeros((bsz, DN_HEADS, HEAD_DIM, HEAD_DIM), jnp.float32)
    oc_f, s_f = gated_delta_rule(qc, kc, vc, gc[:, :, 0], bc[:, :, 0], zero)
    oc_b, s_b = gated_delta_rule(flip(qc), flip(kc), flip(vc), flip(gc[:, :, 1]), flip(bc[:, :, 1]), zero)
    ol_f, _ = gated_delta_rule(ql, kl, vl, gl[:, :, 0], bl[:, :, 0], s_f)
    ol_b, _ = gated_delta_rule(flip(ql), flip(kl), flip(vl), flip(gl[:, :, 1]), flip(bl[:, :, 1]), s_b)
    ol = out_gate(ol_f + flip(ol_b), zl)
    oc = out_gate(oc_f + flip(oc_b), zc) if need_ctx else None
    return oc, ol


def token_mixers(p_ctx, p_lat, ang_row, ang_col, gmlp_ln_g, gmlp_ln_b, gmlp_w_s, gmlp_b_s,
                 attn_q_g, attn_k_g, dn_conv_w, dn_a_log, dn_dt_bias, dn_norm_g, need_ctx):
    s_a, s_b = A_COLS, A_COLS + B_COLS
    ya_l = chunk_token_mlp(p_lat[..., :s_a], gmlp_ln_g, gmlp_ln_b, gmlp_w_s, gmlp_b_s)
    yb_c, yb_l = gqa_mixer(p_ctx[..., s_a:s_b], p_lat[..., s_a:s_b], attn_q_g, attn_k_g, ang_row, ang_col, need_ctx)
    yc_c, yc_l = deltanet_mixer(p_ctx[..., s_b:], p_lat[..., s_b:], dn_conv_w, dn_a_log, dn_dt_bias, dn_norm_g, need_ctx)
    y_lat = jnp.concatenate([ya_l, yb_l, yc_l], -1)
    y_ctx = None
    if need_ctx:
        ya_c = chunk_token_mlp(p_ctx[..., :s_a], gmlp_ln_g, gmlp_ln_b, gmlp_w_s, gmlp_b_s)
        y_ctx = jnp.concatenate([ya_c, yb_c, yc_c], -1)
    return y_ctx, y_lat


def deepnorm_update(x, branch, gate, ln_g, ln_b):
    return layer_norm(DEEPNORM_ALPHA * x + gate * branch, ln_g, ln_b)


def sq_relu_mlp(h, w_up, w_down):
    return jnp.square(jax.nn.relu(h @ w_up)) @ w_down


def setup_inputs(seed: int = 0) -> dict:
    key = jax.random.key(seed)
    ks = jax.random.split(key, 26)
    f32 = jnp.float32
    nrm = lambda k, shape, scale: jax.random.normal(k, shape, f32) * scale
    L, D = DEPTH, D_MODEL
    dt = jnp.exp(jax.random.uniform(ks[16], (L, 2, DN_HEADS), f32, math.log(1e-3), math.log(1e-1)))
    return {
        "x": nrm(ks[0], (BATCH, SEQ, D), 1.0),
        "c": nrm(ks[1], (BATCH, D), 1.0),
        "ctx": nrm(ks[2], (BATCH, CTX_LEN, D), 1.0),
        "c_ctx": nrm(ks[3], (D,), 1.0),
        "mod_w": nrm(ks[4], (L, D, 6 * D), D ** -0.5),
        "mod_b": nrm(ks[5], (L, 6 * D), 0.01),
        "w_in": nrm(ks[6], (L, D, IN_COLS), D ** -0.5),
        "w_out": nrm(ks[7], (L, MIX_WIDTH, D), MIX_WIDTH ** -0.5 * DEEPNORM_BETA),
        "gmlp_ln_g": 1.0 + nrm(ks[8], (L, A_WIDTH), 0.02),
        "gmlp_ln_b": nrm(ks[9], (L, A_WIDTH), 0.02),
        "gmlp_w_s": nrm(ks[10], (L, A_GROUPS, MLP_CHUNK, MLP_CHUNK), MLP_CHUNK ** -0.5),
        "gmlp_b_s": 1.0 + nrm(ks[11], (L, A_GROUPS, MLP_CHUNK), 0.02),
        "attn_q_g": 1.0 + nrm(ks[12], (L, HEAD_DIM), 0.02),
        "attn_k_g": 1.0 + nrm(ks[13], (L, HEAD_DIM), 0.02),
        "dn_conv_w": nrm(ks[14], (L, DN_CONV, 3 * DN_WIDTH), DN_CONV ** -0.5),
        "dn_a_log": jnp.log(jax.random.uniform(ks[15], (L, 2, DN_HEADS), f32, 1.0, 16.0)),
        "dn_dt_bias": dt + jnp.log(-jnp.expm1(-dt)),
        "dn_norm_g": 1.0 + nrm(ks[17], (L, HEAD_DIM), 0.02),
        "ln1_g": 1.0 + nrm(ks[18], (L, D), 0.02),
        "ln1_b": nrm(ks[19], (L, D), 0.02),
        "ln2_g": 1.0 + nrm(ks[20], (L, D), 0.02),
        "ln2_b": nrm(ks[21], (L, D), 0.02),
        "w_up": nrm(ks[22], (L, D, D_FF), D ** -0.5),
        "w_down": nrm(ks[23], (L, D_FF, D), D_FF ** -0.5 * DEEPNORM_BETA),
    }


def reference(x, c, ctx, c_ctx, mod_w, mod_b, w_in, w_out, gmlp_ln_g, gmlp_ln_b, gmlp_w_s, gmlp_b_s,
              attn_q_g, attn_k_g, dn_conv_w, dn_a_log, dn_dt_bias, dn_norm_g,
              ln1_g, ln1_b, ln2_g, ln2_b, w_up, w_down):
    n = x.shape[1]
    rows = n // GRID_W
    ang_row, ang_col = axial_rope_angles(rows)
    x_lat, x_ctx = x, ctx
    for i in range(DEPTH):
        need_ctx = i < DEPTH - 1
        mod_l = (jax.nn.silu(c) @ mod_w[i] + mod_b[i])[:, None, :]
        mod_c = (jax.nn.silu(c_ctx) @ mod_w[i] + mod_b[i])[None, None, :]
        sh1_l, sc1_l, g1_l, sh2_l, sc2_l, g2_l = jnp.split(mod_l, 6, -1)
        sh1_c, sc1_c, g1_c, sh2_c, sc2_c, g2_c = jnp.split(mod_c, 6, -1)
        p_lat = modulate(x_lat, sh1_l, sc1_l) @ w_in[i]
        p_ctx = modulate(x_ctx, sh1_c, sc1_c) @ w_in[i]
        y_ctx, y_lat = token_mixers(p_ctx, p_lat, ang_row, ang_col, gmlp_ln_g[i], gmlp_ln_b[i], gmlp_w_s[i],
                                    gmlp_b_s[i], attn_q_g[i], attn_k_g[i], dn_conv_w[i], dn_a_log[i],
                                    dn_dt_bias[i], dn_norm_g[i], need_ctx)
        x_lat = deepnorm_update(x_lat, y_lat @ w_out[i], g1_l, ln1_g[i], ln1_b[i])
        m_lat = sq_relu_mlp(modulate(x_lat, sh2_l, sc2_l), w_up[i], w_down[i])
        x_lat = deepnorm_update(x_lat, m_lat, g2_l, ln2_g[i], ln2_b[i])
        if need_ctx:
            x_ctx = deepnorm_update(x_ctx, y_ctx @ w_out[i], g1_c, ln1_g[i], ln1_b[i])
            m_ctx = sq_relu_mlp(modulate(x_ctx, sh2_c, sc2_c), w_up[i], w_down[i])
            x_ctx = deepnorm_update(x_ctx, m_ctx, g2_c, ln2_g[i], ln2_b[i])
    return x_lat
```

```cpp
#include <hip/hip_runtime.h>
#include <hip/hip_cooperative_groups.h>
#include <cstdio>
#include <cstdint>
namespace cg = cooperative_groups;
namespace pg8 {
#define PG8_LAS __attribute__((address_space(3)))
typedef unsigned short bf16_t;
typedef short bf16x8 __attribute__((ext_vector_type(8)));
typedef float f32x4 __attribute__((ext_vector_type(4)));
typedef unsigned u32x4 __attribute__((ext_vector_type(4)));
constexpr int BM = 256, BK = 64, HALF = 128, HTB = HALF * BK * 2  , STAGE_BYTES = 8 * HTB, NXCD = 8, WGM = 8;

__host__ __device__ __forceinline__ int lds_byte(int r, int c) { const int st = (r >> 4) * 2 + (c >> 5), rr = r & 15, cc = c & 31, ob = rr * 64 + cc * 2; return st * 1024 + (ob ^ (((ob >> 9) & 1) << 5)); }
__host__ __device__ __forceinline__ void stage_rc(int b, int& R, int& C) { const int st = b / 1024, sb = b % 1024, swz = sb ^ (((sb >> 9) & 1) << 5); R = (st >> 1) * 16 + swz / 64; C = (st & 1) * 32 + (swz % 64) / 2; }
__host__ __device__ __forceinline__ int perm32(int rho) { const int n = rho >> 4, i = rho & 15; return 8 * (i >> 2) + 4 * n + (i & 3); }

struct Unit { int pm, pn; };
struct Gemm { const bf16_t* A; const bf16_t* Bt; int M, N, K, lda; };

struct StaticOrder {
    int nM, nN, nwg, G, c;
    __host__ __device__ void init(int M, int N, int G_, int c_) { nM = M / BM; nN = N / BM; nwg = nM * nN; G = G_; c = c_; }
    __host__ __device__ bool next(int i, Unit& u) const {
        const long L = (long)i * G + c; if (L >= nwg) return false;
        int wgid = (int)L; { const int q = nwg / NXCD, r = nwg % NXCD, xcd = wgid % NXCD, off = wgid / NXCD; wgid = (xcd < r ? xcd * (q + 1) : r * (q + 1) + (xcd - r) * q) + off; }
        const int nig = WGM * nN, gid = wgid / nig, fm = gid * WGM, gsz = (nM - fm) < WGM ? (nM - fm) : WGM;
        u.pm = fm + ((wgid % nig) % gsz); u.pn = (wgid % nig) / gsz; return true;
    }
    __device__ __forceinline__ void a_ready(const Unit&) const {}
    __device__ __forceinline__ void done(const Unit&) const {}
};

__device__ __forceinline__ unsigned cvt_pk_bf16(float lo, float hi) { unsigned r; asm volatile("v_cvt_pk_bf16_f32 %0, %1, %2" : "=v"(r) : "v"(lo), "v"(hi)); return r; }
template <class Epi, class Sched, bool ALIGN_EPI = false, bool SP2 = false>
__device__ __forceinline__ void gemm_phase(PG8_LAS unsigned char* lds, const Gemm g, const Sched& S, const Epi& E) {
    int tid_ = threadIdx.x; asm volatile("" : "+v"(tid_)); const int tid = tid_, wid = __builtin_amdgcn_readfirstlane(tid >> 6), lane = tid & 63, wr = wid >> 2, wc = wid & 3, fr = lane & 15, fq = lane >> 4;
    const int K = g.K, nt = K / BK;
    unsigned voffA[2], voffB[2];
#pragma unroll
    for (int i = 0; i < 2; ++i) { int R, C; stage_rc(tid * 16 + i * 8192, R, C); const int Rb = Epi::PERM ? ((R & ~31) + perm32(R & 31)) : R;
        voffA[i] = (unsigned)(R * g.lda + C) * 2u; voffB[i] = (unsigned)(Rb * K + C) * 2u; }
    const size_t kstep = (size_t)(BK * 2);
    const size_t hstepA = (size_t)HALF * g.lda * 2, hstepB = (size_t)HALF * K * 2;
    const size_t tstepA = 2 * hstepA, tstepB = 2 * hstepB;
    const unsigned ldsw = (unsigned)wid * 1024u;
    const int aoff = lds_byte(wr * 64 + fr, fq * 8), boff = lds_byte(wc * 32 + fr, fq * 8);
#define PG8_SA(b, h) (((b) * 2 + (h)) * HTB)
#define PG8_SB(b, h) ((4 + (b) * 2 + (h)) * HTB)
#define PG8_STAGE(bufoff, gbase, voff) do { _Pragma("unroll") for (int _i = 0; _i < 2; ++_i) \
        __builtin_amdgcn_global_load_lds((const unsigned*)((const char*)(gbase) + (voff)[_i]), (PG8_LAS unsigned*)(lds + (bufoff) + ldsw + _i * 8192), 16, 0, 0); } while (0)
#define PG8_LDA(dst, b, h) do { _Pragma("unroll") for (int m = 0; m < 4; ++m) _Pragma("unroll") for (int k = 0; k < 2; ++k) dst[m][k] = *(const PG8_LAS bf16x8*)(lds + PG8_SA(b, h) + aoff + m * 2048 + k * 1024); } while (0)
#define PG8_LDB(dst, b, h) do { _Pragma("unroll") for (int n = 0; n < 2; ++n) _Pragma("unroll") for (int k = 0; k < 2; ++k) dst[n][k] = *(const PG8_LAS bf16x8*)(lds + PG8_SB(b, h) + boff + n * 2048 + k * 1024); } while (0)
#define PG8_MMA(ai, bj, At, Bt) do { __builtin_amdgcn_s_setprio(1); _Pragma("unroll") for (int m = 0; m < 4; ++m) _Pragma("unroll") for (int n = 0; n < 2; ++n) _Pragma("unroll") for (int k = 0; k < 2; ++k) \
        acc[ai][bj][m][n] = __builtin_amdgcn_mfma_f32_16x16x32_bf16(Bt[n][k], At[m][k], acc[ai][bj][m][n], 0, 0, 0); __builtin_amdgcn_s_setprio(0); } while (0)
#define PG8_WAIT_V(n) asm volatile("s_waitcnt vmcnt(" #n ")" ::: "memory")
#define PG8_WAIT_L(n) asm volatile("s_waitcnt lgkmcnt(" #n ")" ::: "memory")
#define PG8_BAR __builtin_amdgcn_s_barrier()
#define PG8_SCHED __builtin_amdgcn_sched_barrier(0)
    Unit cur, nxt; int ui = 0;
    if (!S.next(0, cur)) return;
    f32x4 acc[2][2][4][2];
#pragma unroll
    for (int a = 0; a < 2; ++a)
#pragma unroll
        for (int b = 0; b < 2; ++b)
#pragma unroll
            for (int m = 0; m < 4; ++m)
#pragma unroll
                for (int n = 0; n < 2; ++n) acc[a][b][m][n] = (f32x4){0.f, 0.f, 0.f, 0.f};
    bf16x8 At[4][2], B0[2][2], B1[2][2];
    const char* cA = (const char*)g.A + (size_t)cur.pm * tstepA; const char* cB = (const char*)g.Bt + (size_t)cur.pn * tstepB;
    S.a_ready(cur);
    if constexpr (SP2) {
        PG8_STAGE(PG8_SB(0, 0), cB, voffB); PG8_STAGE(PG8_SB(0, 1), cB + hstepB, voffB); PG8_STAGE(PG8_SA(0, 0), cA, voffA); PG8_STAGE(PG8_SA(0, 1), cA + hstepA, voffA);
        if (wr == 1) PG8_BAR;
        PG8_WAIT_V(2); PG8_BAR;
        PG8_STAGE(PG8_SB(1, 0), cB + kstep, voffB); PG8_STAGE(PG8_SA(1, 0), cA + kstep, voffA); PG8_STAGE(PG8_SB(1, 1), cB + hstepB + kstep, voffB);
        PG8_WAIT_V(6); PG8_BAR;
    } else {
        PG8_STAGE(PG8_SB(0, 0), cB, voffB); PG8_STAGE(PG8_SA(0, 0), cA, voffA); PG8_STAGE(PG8_SB(0, 1), cB + hstepB, voffB); PG8_STAGE(PG8_SA(0, 1), cA + hstepA, voffA);
        if (wr == 1) PG8_BAR;
        PG8_WAIT_V(4); PG8_BAR;
        PG8_STAGE(PG8_SB(1, 0), cB + kstep, voffB); PG8_STAGE(PG8_SA(1, 0), cA + kstep, voffA); PG8_STAGE(PG8_SB(1, 1), cB + hstepB + kstep, voffB);
        PG8_WAIT_V(6); PG8_BAR;
    }
    for (;;) {
        const bool has_next = S.next(ui + 1, nxt);
        const char* nA = has_next ? (const char*)g.A + (size_t)nxt.pm * tstepA : cA; const char* nB = has_next ? (const char*)g.Bt + (size_t)nxt.pn * tstepB : cB;
        for (int t = 0; t < nt; t += 2) {
            const bool last = (t == nt - 2);
            const char* a1 = cA + (size_t)(t + 1) * kstep;
            const char* a2 = last ? nA : cA + (size_t)(t + 2) * kstep; const char* b2 = last ? nB : cB + (size_t)(t + 2) * kstep;
            const char* a3 = a2 + kstep; const char* b3 = b2 + kstep;
            if (last && has_next) S.a_ready(nxt);
            if constexpr (SP2) {
            PG8_LDB(B0, 0, 0); PG8_LDB(B1, 0, 1); PG8_SCHED; PG8_LDA(At, 0, 0); PG8_STAGE(PG8_SA(1, 1), a1 + hstepA, voffA);
            PG8_WAIT_V(8); PG8_WAIT_L(0); PG8_BAR; PG8_MMA(0, 0, At, B0); PG8_MMA(0, 1, At, B1); PG8_BAR; PG8_SCHED;
            PG8_LDA(At, 0, 1); PG8_STAGE(PG8_SB(0, 0), b2, voffB); PG8_STAGE(PG8_SB(0, 1), b2 + hstepB, voffB); PG8_STAGE(PG8_SA(0, 0), a2, voffA);
            PG8_WAIT_V(8); PG8_WAIT_L(0); PG8_BAR; PG8_MMA(1, 0, At, B0); PG8_MMA(1, 1, At, B1); PG8_BAR; PG8_SCHED;
            PG8_LDB(B0, 1, 0); PG8_LDB(B1, 1, 1); PG8_SCHED; PG8_LDA(At, 1, 0); PG8_STAGE(PG8_SA(0, 1), a2 + hstepA, voffA);
            PG8_WAIT_V(8); PG8_WAIT_L(0); PG8_BAR; PG8_MMA(0, 0, At, B0); PG8_MMA(0, 1, At, B1); PG8_BAR; PG8_SCHED;
            PG8_LDA(At, 1, 1); PG8_STAGE(PG8_SB(1, 0), b3, voffB); PG8_STAGE(PG8_SB(1, 1), b3 + hstepB, voffB); PG8_STAGE(PG8_SA(1, 0), a3, voffA);
            PG8_WAIT_V(8); PG8_WAIT_L(0); PG8_BAR; PG8_MMA(1, 0, At, B0); PG8_MMA(1, 1, At, B1); PG8_BAR; PG8_SCHED;
            } else {
            PG8_LDB(B0, 0, 0); PG8_SCHED; PG8_LDA(At, 0, 0); PG8_STAGE(PG8_SA(1, 1), a1 + hstepA, voffA);
            PG8_WAIT_L(8); PG8_BAR; PG8_WAIT_L(0); PG8_MMA(0, 0, At, B0); PG8_BAR; PG8_SCHED;
            PG8_LDB(B1, 0, 1); PG8_STAGE(PG8_SB(0, 0), b2, voffB);
            PG8_BAR; PG8_WAIT_L(0); PG8_MMA(0, 1, At, B1); PG8_BAR;
            PG8_LDA(At, 0, 1); PG8_STAGE(PG8_SA(0, 0), a2, voffA);
            PG8_BAR; PG8_WAIT_L(0); PG8_MMA(1, 0, At, B0); PG8_BAR; PG8_SCHED;
            PG8_STAGE(PG8_SB(0, 1), b2 + hstepB, voffB);
            PG8_WAIT_V(6); PG8_BAR; PG8_MMA(1, 1, At, B1); PG8_BAR;
            PG8_LDB(B0, 1, 0); PG8_SCHED; PG8_LDA(At, 1, 0); PG8_STAGE(PG8_SA(0, 1), a2 + hstepA, voffA);
            PG8_WAIT_L(8); PG8_BAR; PG8_WAIT_L(0); PG8_MMA(0, 0, At, B0); PG8_BAR; PG8_SCHED;
            PG8_LDB(B1, 1, 1); PG8_STAGE(PG8_SB(1, 0), b3, voffB);
            PG8_BAR; PG8_WAIT_L(0); PG8_MMA(0, 1, At, B1); PG8_BAR;
            PG8_LDA(At, 1, 1); PG8_STAGE(PG8_SA(1, 0), a3, voffA);
            PG8_BAR; PG8_WAIT_L(0); PG8_MMA(1, 0, At, B0); PG8_BAR; PG8_SCHED;
            PG8_STAGE(PG8_SB(1, 1), b3 + hstepB, voffB);
            PG8_WAIT_V(6); PG8_BAR; PG8_MMA(1, 1, At, B1); PG8_BAR;
            }
        }
        if constexpr (ALIGN_EPI) { if (wr == 0) PG8_BAR; }
        if constexpr (!Epi::AFTER_DRAIN) { E(acc, cur, wr, wc, fr, fq); S.done(cur); }
        if (!has_next) break;
#pragma unroll
        for (int a = 0; a < 2; ++a)
#pragma unroll
            for (int b = 0; b < 2; ++b)
#pragma unroll
                for (int m = 0; m < 4; ++m)
#pragma unroll
                    for (int n = 0; n < 2; ++n) acc[a][b][m][n] = (f32x4){0.f, 0.f, 0.f, 0.f};
        cur = nxt; cA = nA; cB = nB; ++ui;
        if constexpr (ALIGN_EPI) { if (wr == 1) PG8_BAR; }
    }
    PG8_WAIT_V(0);
    if constexpr (!ALIGN_EPI) { if (wr == 0) PG8_BAR; }
    PG8_BAR;
    if constexpr (Epi::AFTER_DRAIN) { E.fused(acc, cur, wr, wc, fr, fq, lds, wid, lane); S.done(cur); }
#undef PG8_SA
#undef PG8_SB
#undef PG8_STAGE
#undef PG8_LDA
#undef PG8_LDB
#undef PG8_MMA
#undef PG8_WAIT_V
#undef PG8_WAIT_L
#undef PG8_BAR
#undef PG8_SCHED
}
}
#include <hip/hip_bf16.h>
#include <cmath>
namespace attn_body {
using bf16=__hip_bfloat16;
using bf16x8=__attribute__((ext_vector_type(8)))short;
using s16x4=__attribute__((ext_vector_type(4)))short;
using f32x16=__attribute__((ext_vector_type(16)))float;
using u32x4=__attribute__((ext_vector_type(4)))unsigned;
constexpr int D=64,DM=2816;
constexpr int NW=8,QBLK=32,QB=QBLK*NW,KVBLK=64;
constexpr int ATTN_PITCH=DM, ATTN_UNIT_ROWS=QB;
__device__ __forceinline__ int crow(int r,int hi){return (r&3)+8*(r>>2)+4*hi;}
#define SBAR() __builtin_amdgcn_sched_barrier(0)
__device__ __forceinline__ void cmask(f32x16&p0,f32x16&p1,int jb,int qrel,int hi){
  const float NEG=-INFINITY; int kb=64*jb+4*hi;
  #pragma unroll
  for(int r=0;r<16;++r){int kv=kb+(r&3)+8*(r>>2); if(kv>qrel)p0[r]=NEG; if(kv+32>qrel)p1[r]=NEG;}
}

constexpr int NSLOT=3, SLOTB=8192;
constexpr int LDS_K=0, LDS_V=NSLOT*SLOTB, LDS_WS=2*NSLOT*SLOTB, LDS_OST=LDS_WS+NW*64*4, LDS_BYTES=LDS_OST+NW*4096;
constexpr float C2=0.125f*1.4426950408889634f;
__device__ __forceinline__ void glds16(const void*gsrc,unsigned lds_dst){unsigned keep;
  asm volatile("s_mov_b32 %0, m0\n\ts_mov_b32 m0, %2\n\ts_nop 0\n\tglobal_load_lds_dwordx4 %1, off\n\ts_mov_b32 m0, %0":"=&s"(keep):"v"(gsrc),"s"(lds_dst):"memory");}
__device__ __forceinline__ float max3f(float a,float b,float c){float r;asm("v_max3_f32 %0, %1, %2, %3":"=v"(r):"v"(a),"v"(b),"v"(c));return r;}
__device__ __forceinline__ float max2f(float a,float b){float r;asm("v_max_f32_e32 %0, %1, %2":"=v"(r):"v"(a),"v"(b));return r;}
__device__ __forceinline__ float fadd_s(float a,float b){float r;asm("v_add_f32_e32 %0, %1, %2":"=v"(r):"v"(a),"v"(b));return r;}
__device__ __forceinline__ float fsub_s(float a,float b){float r;asm("v_sub_f32_e32 %0, %1, %2":"=v"(r):"v"(a),"v"(b));return r;}
typedef float f32x2_t __attribute__((ext_vector_type(2))); typedef __bf16 bf16x2_t __attribute__((ext_vector_type(2)));
__device__ __forceinline__ unsigned cvtpk_s(float lo,float hi){f32x2_t v={lo,hi};bf16x2_t b=__builtin_convertvector(v,bf16x2_t);return __builtin_bit_cast(unsigned,b);}
#define WAIT_BAR(N) asm volatile("s_waitcnt vmcnt(" #N ") lgkmcnt(0)\n\ts_barrier":::"memory")

__device__ __forceinline__ void qkt(f32x16&p0,f32x16&p1,const char*Kslot,const bf16x8*qr,const f32x16&negm,int r32,int hi){
  const char*kb=Kslot+hi*1024+r32*16;
  #pragma unroll
  for(int d0=0;d0<4;++d0){
    const bf16x8 b0=*reinterpret_cast<const bf16x8*>(kb+d0*2048);
    const bf16x8 b1=*reinterpret_cast<const bf16x8*>(kb+d0*2048+512);
    if(d0==0){p0=__builtin_amdgcn_mfma_f32_32x32x16_bf16(b0,qr[0],negm,0,0,0);p1=__builtin_amdgcn_mfma_f32_32x32x16_bf16(b1,qr[0],negm,0,0,0);}
    else{p0=__builtin_amdgcn_mfma_f32_32x32x16_bf16(b0,qr[d0],p0,0,0,0);p1=__builtin_amdgcn_mfma_f32_32x32x16_bf16(b1,qr[d0],p1,0,0,0);}}
}
typedef __attribute__((address_space(3))) const char* lds_cptr;
typedef short v4i16_t __attribute__((ext_vector_type(4)));
__device__ __forceinline__ void kload8(bf16x8*kf,lds_cptr kp){
  kf[0]=*(const __attribute__((address_space(3))) bf16x8*)(kp);      kf[1]=*(const __attribute__((address_space(3))) bf16x8*)(kp+512);
  kf[2]=*(const __attribute__((address_space(3))) bf16x8*)(kp+2048); kf[3]=*(const __attribute__((address_space(3))) bf16x8*)(kp+2560);
  kf[4]=*(const __attribute__((address_space(3))) bf16x8*)(kp+4096); kf[5]=*(const __attribute__((address_space(3))) bf16x8*)(kp+4608);
  kf[6]=*(const __attribute__((address_space(3))) bf16x8*)(kp+6144); kf[7]=*(const __attribute__((address_space(3))) bf16x8*)(kp+6656);
}
__device__ __forceinline__ void kload2(bf16x8*kf,lds_cptr kp,int j){ kf[2*j]=*(const __attribute__((address_space(3))) bf16x8*)(kp+j*2048); kf[2*j+1]=*(const __attribute__((address_space(3))) bf16x8*)(kp+j*2048+512); }
__device__ __forceinline__ s16x4 vtr(lds_cptr p){ return __builtin_bit_cast(s16x4,__builtin_amdgcn_ds_read_tr16_b64_v4i16((__attribute__((address_space(3))) v4i16_t*)p)); }
__device__ __forceinline__ float rowmax(const f32x16&p0,const f32x16&p1){
  float a=max3f(p0[0],p0[1],p1[0]),b=max3f(p0[2],p0[3],p1[1]);a=max3f(a,p1[2],p1[3]);
  #pragma unroll
  for(int r=4;r<16;r+=4){a=max3f(a,p0[r],p0[r+1]);b=max3f(b,p0[r+2],p0[r+3]);a=max3f(a,p1[r],p1[r+1]);b=max3f(b,p1[r+2],p1[r+3]);}
  const float m=max2f(a,b);
  auto rr=__builtin_amdgcn_permlane32_swap(__float_as_uint(m),__float_as_uint(m),false,false);
  return max2f(__uint_as_float(rr[0]),__uint_as_float(rr[1]));
}
__device__ __forceinline__ void pv(f32x16*o,int vb,bf16x8 pa0,bf16x8 pa1,bf16x8 pa2,bf16x8 pa3){
  #pragma unroll
  for(int d0=0;d0<2;++d0){s16x4 lo[4],hi[4];
    #pragma unroll
    for(int ks=0;ks<4;++ks){
      asm volatile("ds_read_b64_tr_b16 %0,%1 offset:%c2":"=&v"(lo[ks]):"v"(vb),"i"(d0*4096+ks*1024):"memory");
      asm volatile("ds_read_b64_tr_b16 %0,%1 offset:%c2":"=&v"(hi[ks]):"v"(vb),"i"(d0*4096+ks*1024+512):"memory");}
    asm volatile("s_waitcnt lgkmcnt(0)":::"memory");SBAR();
    #define PK(k) (bf16x8){lo[k][0],lo[k][1],lo[k][2],lo[k][3],hi[k][0],hi[k][1],hi[k][2],hi[k][3]}
    o[d0]=__builtin_amdgcn_mfma_f32_32x32x16_bf16(pa0,PK(0),o[d0],0,0,0);
    o[d0]=__builtin_amdgcn_mfma_f32_32x32x16_bf16(pa1,PK(1),o[d0],0,0,0);
    o[d0]=__builtin_amdgcn_mfma_f32_32x32x16_bf16(pa2,PK(2),o[d0],0,0,0);
    o[d0]=__builtin_amdgcn_mfma_f32_32x32x16_bf16(pa3,PK(3),o[d0],0,0,0);
    #undef PK
  }
}

#ifndef ATTN_STORE16
#define ATTN_STORE16(p,v) (*(u32x4*)(p)=(v))
#endif
template<int THRL> __device__ __forceinline__ void attn_unit(const bf16*Qb,const bf16*Kh,const bf16*Vh,bf16*Ob,const int NT,char*shm){
  int tid_=threadIdx.x; asm volatile("":"+v"(tid_)); const int tid=tid_,lane=tid&63,r32=lane&31,hi=lane>>5; const int wid=__builtin_amdgcn_readfirstlane(tid>>6);
  const bf16*Qw=Qb+(long)(wid*QBLK)*DM;
  const unsigned lds0=(unsigned)(uintptr_t)shm;
  float*wsf=(float*)(shm+LDS_WS)+wid*64;
  const bf16*ksrc=Kh+(long)lane*DM+wid*8;
  const bf16*vsrc=Vh+(long)(16*(wid&3)+(lane>>2))*DM+(wid>>2)*32+(lane&3)*8;
  const unsigned kdst=lds0+LDS_K+wid*1024, vdst=lds0+LDS_V+wid*1024;
  #define DMA_K(t,slot) glds16(ksrc+(long)(t)*KVBLK*DM,(unsigned)__builtin_amdgcn_readfirstlane(kdst+(slot)))
  #define DMA_V(t,slot) glds16(vsrc+(long)(t)*KVBLK*DM,(unsigned)__builtin_amdgcn_readfirstlane(vdst+(slot)))
  const int vb0=(int)(lds0+LDS_V)+((lane>>4)&1)*32+(lane&3)*8+(4*hi+((lane&15)>>2))*64;
  const char*Kbase=shm+LDS_K; bf16x8 kf[8];
  const lds_cptr shm3=(lds_cptr)shm; const lds_cptr kp0=shm3+LDS_K+hi*1024+r32*16; const lds_cptr vp0=shm3+LDS_V+((lane>>4)&1)*32+(lane&3)*8+(4*hi+((lane&15)>>2))*64;
  DMA_K(0,0);DMA_V(0,0);DMA_K(1,SLOTB);
  bf16x8 qr[4];
  #pragma unroll
  for(int d0=0;d0<4;++d0)qr[d0]=*reinterpret_cast<const bf16x8*>(&Qw[(long)r32*DM+d0*16+hi*8]);
  float mhat=0.f,l_reg=0.f;f32x16 o[2];o[0]=f32x16{};o[1]=f32x16{};f32x16 negm=f32x16{};asm volatile("":"+v"(negm));
  #define CMASK(P0,P1,t) do{}while(0)
  bool resc=false;
  #define START(P0,P1) do{ const float rm=rowmax(P0,P1); resc=false; \
    { const float dl=rm; mhat=fadd_s(mhat,dl); \
      _Pragma("unroll") for(int r=0;r<16;++r){P0[r]=fsub_s(P0[r],dl);P1[r]=fsub_s(P1[r],dl);} \
      _Pragma("unroll") for(int r=0;r<16;++r)negm[r]=-mhat; asm volatile("":"+v"(negm)); } \
    _Pragma("unroll") for(int r=0;r<16;++r)P0[r]=__builtin_amdgcn_exp2f(P0[r]); }while(0)
  #define RESC() do{ if(resc){ asm volatile("s_waitcnt lgkmcnt(0)":::"memory"); \
      _Pragma("unroll") for(int d_=0;d_<2;++d_) _Pragma("unroll") for(int r=0;r<16;++r)o[d_][r]*=wsf[crow(r,hi)]; } }while(0)
  f32x16 pA0,pA1,pB0,pB1;
  int sl_prev=0,sl_cur=0,sl_next=SLOTB;
  #define ROT() do{sl_prev=sl_cur;sl_cur=sl_next;sl_next=(sl_next==(NSLOT-1)*SLOTB)?0:sl_next+SLOTB;}while(0)
  DMA_K(2,2*SLOTB);
  WAIT_BAR(3);
  qkt(pA0,pA1,Kbase,qr,negm,r32,hi);asm volatile("s_nop 15\n\ts_nop 7":"+v"(pA0),"+v"(pA1));CMASK(pA0,pA1,0);
  START(pA0,pA1);
  _Pragma("unroll") for(int r=0;r<16;++r)pA1[r]=__builtin_amdgcn_exp2f(pA1[r]);
  WAIT_BAR(0);
  DMA_K(3,0);DMA_V(1,SLOTB);
  ROT();
  kload8(kf,kp0+sl_cur);
  WAIT_BAR(2);
  s16x4 vlo[8],vhi[8]; u32x4 pw0,pw1,pw2,pw3;
  #define PKW(P,B) cvtpk_s(P[B],P[B+1])
  #define PAF(k) __builtin_bit_cast(bf16x8,pw##k)
  #define VFR(i) (bf16x8){vlo[i][0],vlo[i][1],vlo[i][2],vlo[i][3],vhi[i][0],vhi[i][1],vhi[i][2],vhi[i][3]}
  #define PIN(x) asm volatile("":"+v"(x))
  #define MX3(a,b,c) __builtin_fmaxf(__builtin_fmaxf((a),(b)),(c))
  #define GAPA(MF,A0,A1,A2,A3,W0,W1,PW) do{ MF; sacc+=A0; sacc+=A1; sacc+=A2; sacc+=A3; PIN(sacc); W0; W1; PIN(PW); SBAR(); }while(0)
  #define EX(v) __builtin_amdgcn_exp2f(v)
  #define GAPB(MF,X,B) do{ MF; X[B]=EX(X[B]); X[B+1]=EX(X[B+1]); X[B+2]=EX(X[B+2]); X[B+3]=EX(X[B+3]); PIN(X); SBAR(); }while(0)
  #define VRD(i) do{ vlo[i]=vtr(vp_+(((i)>>2)*4096+((i)&3)*1024)); vhi[i]=vtr(vp_+(((i)>>2)*4096+((i)&3)*1024+512)); }while(0)
  #define KRD(G,j) do{ if(G){ kload2(kf,kp0+sl_next,j); SBAR(); } }while(0)
  #define STEP(C0,C1,P0,P1,t,GK,GV,GL) do{ SBAR(); \
    const lds_cptr vp_=vp0+sl_prev; \
    VRD(0); SBAR(); float sacc=(P0[0]+P0[1]); \
    GAPA(C0=__builtin_amdgcn_mfma_f32_32x32x16_bf16(kf[0],qr[0],negm,0,0,0), P0[2],P0[3],P0[4],P0[5],     pw0[0]=PKW(P0,0), pw0[1]=PKW(P0,2), pw0); \
    VRD(4); SBAR(); GAPA(C1=__builtin_amdgcn_mfma_f32_32x32x16_bf16(kf[1],qr[0],negm,0,0,0), P0[6],P0[7],P0[8],P0[9],     pw0[2]=PKW(P0,4), pw0[3]=PKW(P0,6), pw0); \
    VRD(1); SBAR(); GAPA(C0=__builtin_amdgcn_mfma_f32_32x32x16_bf16(kf[2],qr[1],C0,0,0,0),   P0[10],P0[11],P0[12],P0[13], pw1[0]=PKW(P0,8), pw1[1]=PKW(P0,10), pw1); \
    VRD(5); SBAR(); GAPA(C1=__builtin_amdgcn_mfma_f32_32x32x16_bf16(kf[3],qr[1],C1,0,0,0),   P0[14],P0[15],P1[0],P1[1],   pw1[2]=PKW(P0,12),pw1[3]=PKW(P0,14), pw1); \
    VRD(2); SBAR(); GAPA(C0=__builtin_amdgcn_mfma_f32_32x32x16_bf16(kf[4],qr[2],C0,0,0,0),   P1[2],P1[3],P1[4],P1[5],     pw2[0]=PKW(P1,0), pw2[1]=PKW(P1,2), pw2); \
    VRD(6); SBAR(); GAPA(C1=__builtin_amdgcn_mfma_f32_32x32x16_bf16(kf[5],qr[2],C1,0,0,0),   P1[6],P1[7],P1[8],P1[9],     pw2[2]=PKW(P1,4), pw2[3]=PKW(P1,6), pw2); \
    VRD(3); SBAR(); GAPA(C0=__builtin_amdgcn_mfma_f32_32x32x16_bf16(kf[6],qr[3],C0,0,0,0),   P1[10],P1[11],P1[12],P1[13], pw3[0]=PKW(P1,8), pw3[1]=PKW(P1,10), pw3); \
    VRD(7); SBAR(); GAPA(C1=__builtin_amdgcn_mfma_f32_32x32x16_bf16(kf[7],qr[3],C1,0,0,0),   P1[14],P1[15],0.f,0.f,       pw3[2]=PKW(P1,12),pw3[3]=PKW(P1,14), pw3); \
    l_reg+=sacc; \
    if(GK){DMA_K((t)+3,sl_cur);} if(GV){DMA_V((t)+1,sl_next);} \
    CMASK(C0,C1,t); \
    { float a=MX3(C0[0],C0[1],C1[0]),b=MX3(C0[2],C0[3],C1[1]); a=MX3(a,C1[2],C1[3]); \
      _Pragma("unroll") for(int r=4;r<16;r+=4){a=MX3(a,C0[r],C0[r+1]);b=MX3(b,C0[r+2],C0[r+3]);a=MX3(a,C1[r],C1[r+1]);b=MX3(b,C1[r+2],C1[r+3]);} \
      float rm=__builtin_fmaxf(a,b); { auto rr=__builtin_amdgcn_permlane32_swap(__float_as_uint(rm),__float_as_uint(rm),false,false); rm=__builtin_fmaxf(__uint_as_float(rr[0]),__uint_as_float(rr[1])); } \
      resc=false; \
      if(__builtin_expect(__any(rm>(float)THRL),0)){ const float dl=__builtin_fmaxf(rm,0.f); mhat+=dl; \
        _Pragma("unroll") for(int r=0;r<16;++r){C0[r]-=dl;C1[r]-=dl;} \
        _Pragma("unroll") for(int r=0;r<16;++r)negm[r]=-mhat; asm volatile("":"+v"(negm)); \
        const float f=__builtin_amdgcn_exp2f(-dl); l_reg*=f; if(hi==0)wsf[r32]=f; resc=true; } } \
    SBAR(); \
    GAPB(o[0]=__builtin_amdgcn_mfma_f32_32x32x16_bf16(PAF(0),VFR(0),o[0],0,0,0), C0,0); \
    GAPB(o[1]=__builtin_amdgcn_mfma_f32_32x32x16_bf16(PAF(0),VFR(4),o[1],0,0,0), C0,4); \
    KRD(GL,0); GAPB(o[0]=__builtin_amdgcn_mfma_f32_32x32x16_bf16(PAF(1),VFR(1),o[0],0,0,0), C0,8); \
    KRD(GL,1); GAPB(o[1]=__builtin_amdgcn_mfma_f32_32x32x16_bf16(PAF(1),VFR(5),o[1],0,0,0), C0,12); \
    KRD(GL,2); GAPB(o[0]=__builtin_amdgcn_mfma_f32_32x32x16_bf16(PAF(2),VFR(2),o[0],0,0,0), C1,0); \
    KRD(GL,3); GAPB(o[1]=__builtin_amdgcn_mfma_f32_32x32x16_bf16(PAF(2),VFR(6),o[1],0,0,0), C1,4); \
    GAPB(o[0]=__builtin_amdgcn_mfma_f32_32x32x16_bf16(PAF(3),VFR(3),o[0],0,0,0), C1,8); \
    GAPB(o[1]=__builtin_amdgcn_mfma_f32_32x32x16_bf16(PAF(3),VFR(7),o[1],0,0,0), C1,12); \
    }while(0)
  int t=1;
  #undef CMASK
  #define CMASK(P0,P1,t) do{}while(0)
  for(;t+5<NT;t+=2){
    STEP(pB0,pB1,pA0,pA1,t,true,true,true);     WAIT_BAR(2); RESC(); ROT();
    STEP(pA0,pA1,pB0,pB1,t+1,true,true,true);   WAIT_BAR(2); RESC(); ROT();
  }
  #undef CMASK
  #define CMASK(P0,P1,t) do{}while(0)
  #define ENDW(tt) do{ if((tt)+3<NT){WAIT_BAR(2);} else if((tt)+2<NT){WAIT_BAR(1);} else {WAIT_BAR(0);} }while(0)
  for(;t+1<NT;t+=2){
    STEP(pB0,pB1,pA0,pA1,t,(t+3<NT),(t+1<NT),(t+1<NT));       ENDW(t);   RESC(); ROT();
    STEP(pA0,pA1,pB0,pB1,t+1,(t+4<NT),(t+2<NT),(t+2<NT));     ENDW(t+1); RESC(); ROT();
  }
  STEP(pB0,pB1,pA0,pA1,NT-1,false,false,false); RESC();
  { float sacc=pB0[0]+pB0[1]; _Pragma("unroll") for(int r=2;r<16;++r)sacc+=pB0[r]; _Pragma("unroll") for(int r=0;r<16;++r)sacc+=pB1[r]; l_reg+=sacc;
    pw0=(u32x4){PKW(pB0,0),PKW(pB0,2),PKW(pB0,4),PKW(pB0,6)};pw1=(u32x4){PKW(pB0,8),PKW(pB0,10),PKW(pB0,12),PKW(pB0,14)};pw2=(u32x4){PKW(pB1,0),PKW(pB1,2),PKW(pB1,4),PKW(pB1,6)};pw3=(u32x4){PKW(pB1,8),PKW(pB1,10),PKW(pB1,12),PKW(pB1,14)};
    SBAR(); pv(o,vb0+sl_cur,PAF(0),PAF(1),PAF(2),PAF(3)); }
  #undef PKW
  #undef PAF
  #undef VFR
  #undef PIN
  #undef MX3
  #undef GAPA
  #undef GAPB
  #undef EX
  #undef VRD
  #undef KRD
  #undef STEP
  #undef ENDW
  {auto rr=__builtin_amdgcn_permlane32_swap(__float_as_uint(l_reg),__float_as_uint(l_reg),false,false);l_reg=__uint_as_float(rr[0])+__uint_as_float(rr[1]);}
  if(hi==0)wsf[32+r32]=l_reg;asm volatile("s_waitcnt lgkmcnt(0)":::"memory");
  float rli[16];
  #pragma unroll
  for(int r=0;r<16;++r)rli[r]=__builtin_amdgcn_rcpf(wsf[32+crow(r,hi)]);
  bf16*Ow=Ob+(long)(wid*QBLK)*DM;
  { bf16*stg=(bf16*)(shm+LDS_OST)+wid*2048;
    #pragma unroll
    for(int r=0;r<16;++r){const int orow=crow(r,hi);
      #pragma unroll
      for(int d0=0;d0<2;++d0)stg[orow*64+d0*32+r32]=__float2bfloat16(o[d0][r]*rli[r]);}
    asm volatile("s_waitcnt lgkmcnt(0)":::"memory");
    #pragma unroll
    for(int i=0;i<4;++i){const int row=i*8+(lane>>3),ch=lane&7; const u32x4 v=*(const u32x4*)(stg+row*64+ch*8); ATTN_STORE16(Ow+(long)row*DM+ch*8,v);} }
  asm volatile("s_waitcnt lgkmcnt(0)\n\ts_barrier":::"memory");
  #undef DMA_K
  #undef DMA_V
  #undef CMASK
  #undef START
  #undef RESC
  #undef ROT
}
constexpr int ATTN_LDS_BYTES=LDS_BYTES;
#undef SBAR
#undef WAIT_BAR
}
typedef unsigned short bf16_t;
typedef float f32x4 __attribute__((ext_vector_type(4)));
typedef unsigned u32x4 __attribute__((ext_vector_type(4)));
typedef unsigned u32x2 __attribute__((ext_vector_type(2)));
typedef short bf16x8 __attribute__((ext_vector_type(8)));

constexpr int NB = 4, SEQL = 4096, CTXL = 256, ROWB = SEQL + CTXL, NROW = NB * ROWB;
constexpr int DM = 1024, PP = 2816, DFF = 4096, NLAYER = 2, INC = 2712, MODW = 6144;
constexpr int NTHR = 512, NWV = 8;
constexpr float LN_EPS = 1e-6f;
constexpr float DN_ALPHA = 1.41421356237309515f;
constexpr int PC_U = 0, PC_AQ = 256, PC_Z = 640, PC_GV = 1024, PC_AK = 1280, PC_AV = 1408, PC_DQ = 1536, PC_DK = 1920, PC_DV = 2304, PC_AB = 2688;
constexpr size_t MiB = 1u << 20;
constexpr size_t WS_P = 0;
constexpr size_t WS_DNSH = 94 * MiB;
constexpr size_t WS_DNPD = WS_DNSH + (size_t)1632 * 16384;
constexpr size_t WS_DNVEC = WS_DNPD + (size_t)3264 * 24576;
constexpr size_t WS_DNEND = WS_DNVEC + (size_t)3264 * 768;
constexpr size_t WS_H = 0;
constexpr size_t WS_XN = 136 * MiB;
constexpr size_t WS_W = 200 * MiB;
constexpr size_t W_IN_OFF = 0, W_OUT_OFF = (size_t)2816 * 1024 * 2, W_UP_OFF = W_OUT_OFF + (size_t)1024 * 1024 * 2, W_DN_OFF = W_UP_OFF + (size_t)4096 * 1024 * 2, W_LAYER = W_DN_OFF + (size_t)4096 * 1024 * 2;
constexpr size_t WS_XCTX = 247 * MiB;
constexpr size_t WS_AB = 251 * MiB;
constexpr size_t WS_MODV = 253 * MiB;
static_assert(WS_DNEND <= 200 * MiB && WS_W + 2 * W_LAYER <= WS_XCTX && WS_AB + (size_t)NROW * 96 <= WS_MODV, "ws map");

__device__ __forceinline__ float bf2f(unsigned v) { return __uint_as_float(v << 16); }
__device__ __forceinline__ unsigned f2bf(float f) { unsigned u = __float_as_uint(f); return (u + 0x7fffu + ((u >> 16) & 1u)) >> 16; }
__device__ __forceinline__ unsigned pk2(float lo, float hi) { return f2bf(lo) | (f2bf(hi) << 16); }
__device__ __forceinline__ float wave_sum(float v) {
#pragma unroll
    for (int o = 1; o < 64; o <<= 1) v += __shfl_xor(v, o);
    return v;
}
__device__ __forceinline__ float gelu_f(float x) { return 0.5f * x * (1.0f + erff(x * 0.70710678118654752f)); }
__device__ __forceinline__ float silu_f(float x) { return x / (1.0f + __expf(-x)); }
__device__ __forceinline__ void unpack8(u32x4 w, float (&f)[8]) {
    f[0] = bf2f(w.x & 0xffffu); f[1] = bf2f(w.x >> 16); f[2] = bf2f(w.y & 0xffffu); f[3] = bf2f(w.y >> 16);
    f[4] = bf2f(w.z & 0xffffu); f[5] = bf2f(w.z >> 16); f[6] = bf2f(w.w & 0xffffu); f[7] = bf2f(w.w >> 16);
}
__device__ __forceinline__ u32x4 pack8(const float (&f)[8]) { u32x4 w; w.x = pk2(f[0], f[1]); w.y = pk2(f[2], f[3]); w.z = pk2(f[4], f[5]); w.w = pk2(f[6], f[7]); return w; }

namespace pg8 {
struct EpiP {
    static constexpr bool PERM = true, AFTER_DRAIN = false;
    bf16_t* P; float* AB;
    __device__ __forceinline__ void operator()(const f32x4 (&acc)[2][2][4][2], const Unit& u, int wr, int wc, int fr, int fq) const {
        const int row0 = u.pm * BM + wr * 64 + fr, col0 = u.pn * BM + wc * 32 + 8 * fq;
#pragma unroll
        for (int ai = 0; ai < 2; ++ai)
#pragma unroll
            for (int m = 0; m < 4; ++m) { const int r = row0 + ai * HALF + m * 16;
#pragma unroll
                for (int bj = 0; bj < 2; ++bj) { const int c = col0 + bj * HALF; const f32x4 v0 = acc[ai][bj][m][0], v1 = acc[ai][bj][m][1];
                    u32x4 w; w.x = cvt_pk_bf16(v0[0], v0[1]); w.y = cvt_pk_bf16(v0[2], v0[3]); w.z = cvt_pk_bf16(v1[0], v1[1]); w.w = cvt_pk_bf16(v1[2], v1[3]);
                    *(u32x4*)(P + (size_t)r * PP + c) = w;
                    if (c >= PC_AB && c < INC) { float* ab = AB + (size_t)r * 24 + (c - PC_AB); *(f32x4*)ab = v0; *(f32x4*)(ab + 4) = v1; } } }
    }
};
struct EpiH {
    static constexpr bool PERM = true, AFTER_DRAIN = false;
    bf16_t* H;
    __device__ __forceinline__ void operator()(const f32x4 (&acc)[2][2][4][2], const Unit& u, int wr, int wc, int fr, int fq) const {
        const int row0 = u.pm * BM + wr * 64 + fr, col0 = u.pn * BM + wc * 32 + 8 * fq;
#pragma unroll
        for (int ai = 0; ai < 2; ++ai)
#pragma unroll
            for (int m = 0; m < 4; ++m) { const int r = row0 + ai * HALF + m * 16;
#pragma unroll
                for (int bj = 0; bj < 2; ++bj) { const int c = col0 + bj * HALF; f32x4 v0 = acc[ai][bj][m][0], v1 = acc[ai][bj][m][1];
#pragma unroll
                    for (int e = 0; e < 4; ++e) { const float a = fmaxf(v0[e], 0.f), b = fmaxf(v1[e], 0.f); v0[e] = a * a; v1[e] = b * b; }
                    u32x4 w; w.x = cvt_pk_bf16(v0[0], v0[1]); w.y = cvt_pk_bf16(v0[2], v0[3]); w.z = cvt_pk_bf16(v1[0], v1[1]); w.w = cvt_pk_bf16(v1[2], v1[3]);
                    *(u32x4*)(H + (size_t)r * DFF + c) = w; } }
    }
};
struct EpiRes {
    static constexpr bool PERM = false, AFTER_DRAIN = false;
    const float* srclat; const float* srcctx; float* dstlat; float* dstctx; const float* gate;
    __device__ __forceinline__ void operator()(const f32x4 (&acc)[2][2][4][2], const Unit& u, int wr, int wc, int fr, int fq) const {
        const int b = u.pm / 17, tt = u.pm - b * 17; const bool lat = tt < 16;
        const float* sp = lat ? srclat + (size_t)(b * SEQL + tt * 256) * DM : srcctx + (size_t)(b * CTXL) * DM;
        float* dp = lat ? dstlat + (size_t)(b * SEQL + tt * 256) * DM : dstctx + (size_t)(b * CTXL) * DM;
        const float* gp = gate + (size_t)(lat ? b : 4) * MODW;
#pragma unroll
        for (int bj = 0; bj < 2; ++bj)
#pragma unroll
            for (int n = 0; n < 2; ++n) { const int col = u.pn * BM + bj * HALF + wc * 32 + n * 16 + 4 * fq; const f32x4 gv = *(const f32x4*)(gp + col);
#pragma unroll
                for (int ai = 0; ai < 2; ++ai)
#pragma unroll
                    for (int m = 0; m < 4; ++m) { const size_t off = (size_t)(ai * HALF + wr * 64 + m * 16 + fr) * DM + col;
                        const f32x4 xv = *(const f32x4*)(sp + off); *(f32x4*)(dp + off) = xv * DN_ALPHA + gv * acc[ai][bj][m][n]; } }
    }
};
}

__device__ __forceinline__ int win_src_col(int n0) {
    if (n0 < 256) return n0;
    if (n0 < 640) return 512 + (n0 - 256);
    if (n0 < 1024) return 2304 + (n0 - 640);
    if (n0 < 1280) return 256 + (n0 - 1024);
    if (n0 < 1408) return 896 + (n0 - 1280);
    if (n0 < 1536) return 1024 + (n0 - 1408);
    if (n0 < 2688) return 1152 + (n0 - 1536);
    return n0;
}
__device__ __forceinline__ void transpose_item(const float* W, int K, int Nsrc, int Npad, bf16_t* WT, float* scr, int item, int lane, bool perm) {
    const int nblk = Npad / 32, kb = item / nblk, nb = item - kb * nblk, k0 = 64 * kb, n0 = 32 * nb;
    const int sn = (perm ? win_src_col(n0) : n0) + (lane & 31);
    const bool ok = sn < Nsrc;
#pragma unroll 8
    for (int i = 0; i < 32; ++i) { const int kk = 2 * i + (lane >> 5); scr[kk * 33 + (lane & 31)] = ok ? W[(size_t)(k0 + kk) * Nsrc + sn] : 0.f; }
    __builtin_amdgcn_s_waitcnt(0); asm volatile("" ::: "memory");
    const int c = lane & 7;
#pragma unroll
    for (int j = 0; j < 4; ++j) { const int n = (lane >> 3) + 8 * j; const float* s = scr + (8 * c) * 33 + n;
        u32x4 o; o.x = pk2(s[0 * 33], s[1 * 33]); o.y = pk2(s[2 * 33], s[3 * 33]); o.z = pk2(s[4 * 33], s[5 * 33]); o.w = pk2(s[6 * 33], s[7 * 33]);
        *(u32x4*)(WT + (size_t)(n0 + n) * K + k0 + 8 * c) = o; }
    __builtin_amdgcn_s_waitcnt(0); asm volatile("" ::: "memory");
}

struct Args { const float* in[24]; float* out; unsigned char* ws; };

__device__ __forceinline__ void phase_prologue(const Args& a, unsigned char* lds, int tid, int lane, int wave, int G) {
    float* sc = (float*)lds;
    float* red = (float*)(lds + 20480);
    const float* c = a.in[1]; const float* cctx = a.in[3]; const float* mod_w = a.in[4]; const float* mod_b = a.in[5];
    float* modv = (float*)(a.ws + WS_MODV);
    for (int i = tid; i < 5120; i += NTHR) { const float v = i < 4096 ? c[i] : cctx[i - 4096]; sc[i] = v / (1.0f + expf(-v)); }
    __syncthreads();
    for (int it = blockIdx.x; it < 192; it += G) {
        const int l = it / 96, cb = it - l * 96, col = cb * 64 + lane, k0 = wave * 128;
        const float* W = mod_w + (size_t)l * 1024 * MODW + col;
        float acc0 = 0.f, acc1 = 0.f, acc2 = 0.f, acc3 = 0.f, acc4 = 0.f;
#pragma unroll 16
        for (int k = 0; k < 128; ++k) { const float wv = W[(size_t)(k0 + k) * MODW];
            acc0 += sc[k0 + k] * wv; acc1 += sc[1024 + k0 + k] * wv; acc2 += sc[2048 + k0 + k] * wv; acc3 += sc[3072 + k0 + k] * wv; acc4 += sc[4096 + k0 + k] * wv; }
        red[(wave * 5 + 0) * 64 + lane] = acc0; red[(wave * 5 + 1) * 64 + lane] = acc1; red[(wave * 5 + 2) * 64 + lane] = acc2; red[(wave * 5 + 3) * 64 + lane] = acc3; red[(wave * 5 + 4) * 64 + lane] = acc4;
        __syncthreads();
        if (tid < 320) { const int s = tid >> 6, ln = tid & 63; float sum = 0.f;
#pragma unroll
            for (int w = 0; w < 8; ++w) sum += red[(w * 5 + s) * 64 + ln];
            modv[(size_t)(l * 5 + s) * MODW + cb * 64 + ln] = sum + mod_b[(size_t)l * MODW + cb * 64 + ln]; }
        __syncthreads();
    }
    float* scr = (float*)(lds + 32768 + wave * 8704);
    const int gw = blockIdx.x * NWV + wave, NGW = G * NWV;
    constexpr int I_IN = 16 * 88, I_OUT = 16 * 32, I_UP = 16 * 128, I_DN = 64 * 32, I_L = I_IN + I_OUT + I_UP + I_DN;
    for (int it = gw; it < 2 * I_L; it += NGW) {
        const int l = it / I_L; int r = it - l * I_L; unsigned char* wb = a.ws + WS_W + (size_t)l * W_LAYER;
        if (r < I_IN) { transpose_item(a.in[6] + (size_t)l * 1024 * INC, 1024, INC, 2816, (bf16_t*)(wb + W_IN_OFF), scr, r, lane, true); continue; } r -= I_IN;
        if (r < I_OUT) { transpose_item(a.in[7] + (size_t)l * 1024 * 1024, 1024, 1024, 1024, (bf16_t*)(wb + W_OUT_OFF), scr, r, lane, false); continue; } r -= I_OUT;
        if (r < I_UP) { transpose_item(a.in[22] + (size_t)l * 1024 * DFF, 1024, DFF, DFF, (bf16_t*)(wb + W_UP_OFF), scr, r, lane, false); continue; } r -= I_UP;
        transpose_item(a.in[23] + (size_t)l * DFF * 1024, DFF, 1024, 1024, (bf16_t*)(wb + W_DN_OFF), scr, r, lane, false);
    }
}

template <int MODE>
__device__ __forceinline__ void ln_rows(const float* srclat, const float* srcctx, float* dstlat, float* dstctx, const float* lng, const float* lnb,
                                        const float* modsh  , bf16_t* XN, bool wantxn, bool latonly,
                                        int lane, int wave, int G) {
    const int gw = blockIdx.x * NWV + wave, NGW = G * NWV;
    for (int r = gw; r < NROW; r += NGW) {
        const int b = r / ROWB, t = r - b * ROWB; const bool lat = t < SEQL;
        if (latonly && !lat) continue;
        const size_t ro = lat ? (size_t)(b * SEQL + t) * DM : (size_t)(b * CTXL + t - SEQL) * DM;
        const float* src = (lat ? srclat : srcctx) + ro;
        f32x4 v[4];
#pragma unroll
        for (int j = 0; j < 4; ++j) v[j] = *(const f32x4*)(src + lane * 4 + 256 * j);
        if (MODE == 1) {
            float s = 0.f;
#pragma unroll
            for (int j = 0; j < 4; ++j) s += (v[j][0] + v[j][1]) + (v[j][2] + v[j][3]);
            const float mean = wave_sum(s) * (1.0f / DM); float q = 0.f;
#pragma unroll
            for (int j = 0; j < 4; ++j) { v[j] = v[j] - mean; q += (v[j][0] * v[j][0] + v[j][1] * v[j][1]) + (v[j][2] * v[j][2] + v[j][3] * v[j][3]); }
            const float rstd = 1.0f / sqrtf(wave_sum(q) * (1.0f / DM) + LN_EPS);
            float* dst = (lat ? dstlat : dstctx) + ro;
#pragma unroll
            for (int j = 0; j < 4; ++j) { const f32x4 g = *(const f32x4*)(lng + lane * 4 + 256 * j), bb = *(const f32x4*)(lnb + lane * 4 + 256 * j);
                v[j] = v[j] * rstd * g + bb; *(f32x4*)(dst + lane * 4 + 256 * j) = v[j]; }
        }
        if (wantxn) {
            float s = 0.f;
#pragma unroll
            for (int j = 0; j < 4; ++j) s += (v[j][0] + v[j][1]) + (v[j][2] + v[j][3]);
            const float mean = wave_sum(s) * (1.0f / DM); float q = 0.f;
#pragma unroll
            for (int j = 0; j < 4; ++j) { v[j] = v[j] - mean; q += (v[j][0] * v[j][0] + v[j][1] * v[j][1]) + (v[j][2] * v[j][2] + v[j][3] * v[j][3]); }
            const float rstd = 1.0f / sqrtf(wave_sum(q) * (1.0f / DM) + LN_EPS);
            const float* sh = modsh + (size_t)(lat ? b : 4) * MODW;
            bf16_t* xo = XN + (size_t)r * DM;
#pragma unroll
            for (int j = 0; j < 4; ++j) { const f32x4 shv = *(const f32x4*)(sh + lane * 4 + 256 * j), scv = *(const f32x4*)(sh + 1024 + lane * 4 + 256 * j);
                const f32x4 o = v[j] * rstd * (scv + 1.0f) + shv; u32x2 w; w.x = pk2(o[0], o[1]); w.y = pk2(o[2], o[3]);
                *(u32x2*)(xo + lane * 4 + 256 * j) = w; }
        }
    }
}

__device__ __forceinline__ void gmlp_item(int ci, bf16_t* P, const float* ln_g, const float* ln_b, const float* w_s, const float* b_s, unsigned char* lds, int tid, int lane, int wave) {
    float* Ws = (float*)lds;
    float* vl = (float*)(lds + 67584);
    float* st = (float*)(lds + 102400);
    const int r0 = ci * 128;
    for (int tt = 0; tt < 16; ++tt) { const int tk = wave * 16 + tt;
        const u32x2 w = *(const u32x2*)(P + (size_t)(r0 + tk) * PP + PC_GV + lane * 4);
        const float x0 = gelu_f(bf2f(w.x & 0xffffu)), x1 = gelu_f(bf2f(w.x >> 16)), x2 = gelu_f(bf2f(w.y & 0xffffu)), x3 = gelu_f(bf2f(w.y >> 16));
        const float mean = wave_sum((x0 + x1) + (x2 + x3)) * (1.0f / 256.0f);
        const float d0 = x0 - mean, d1 = x1 - mean, d2 = x2 - mean, d3 = x3 - mean;
        const float var = wave_sum((d0 * d0 + d1 * d1) + (d2 * d2 + d3 * d3)) * (1.0f / 256.0f);
        if (lane == 0) { st[tk * 2] = mean; st[tk * 2 + 1] = 1.0f / sqrtf(var + LN_EPS); } }
    __syncthreads();
    for (int g = 0; g < 4; ++g) {
#pragma unroll
        for (int k = 0; k < 8; ++k) { const int idx4 = tid + NTHR * k, t = idx4 >> 5, s4 = (idx4 & 31) * 4;
            *(f32x4*)(Ws + t * 132 + s4) = *(const f32x4*)(w_s + (size_t)(g * 128 + t) * 128 + s4); }
#pragma unroll
        for (int k = 0; k < 16; ++k) { const int idx = tid + NTHR * k, s = idx >> 6, d = idx & 63;
            const float x = gelu_f(bf2f(P[(size_t)(r0 + s) * PP + PC_GV + g * 64 + d]));
            vl[s * 68 + d] = (x - st[2 * s]) * st[2 * s + 1] * ln_g[g * 64 + d] + ln_b[g * 64 + d]; }
        __syncthreads();
        const int d4 = tid & 15, tq = tid >> 4;
        f32x4 acc[4];
#pragma unroll
        for (int i = 0; i < 4; ++i) acc[i] = (f32x4){0.f, 0.f, 0.f, 0.f};
        for (int s4 = 0; s4 < 32; ++s4) {
            f32x4 vv[4], wv[4];
#pragma unroll
            for (int k = 0; k < 4; ++k) vv[k] = *(const f32x4*)(vl + (s4 * 4 + k) * 68 + d4 * 4);
#pragma unroll
            for (int i = 0; i < 4; ++i) wv[i] = *(const f32x4*)(Ws + (tq + 32 * i) * 132 + s4 * 4);
#pragma unroll
            for (int i = 0; i < 4; ++i)
#pragma unroll
                for (int k = 0; k < 4; ++k) acc[i] += vv[k] * wv[i][k];
        }
#pragma unroll
        for (int i = 0; i < 4; ++i) { const int t = tq + 32 * i; bf16_t* up = P + (size_t)(r0 + t) * PP + PC_U + g * 64 + d4 * 4;
            const u32x2 w = *(const u32x2*)up; const float bs = b_s[g * 128 + t];
            const float y0 = gelu_f(bf2f(w.x & 0xffffu)) * (acc[i][0] + bs), y1 = gelu_f(bf2f(w.x >> 16)) * (acc[i][1] + bs);
            const float y2 = gelu_f(bf2f(w.y & 0xffffu)) * (acc[i][2] + bs), y3 = gelu_f(bf2f(w.y >> 16)) * (acc[i][3] + bs);
            u32x2 o; o.x = pk2(y0, y1); o.y = pk2(y2, y3); *(u32x2*)up = o; }
        __syncthreads();
    }
}

constexpr float ATT_C2 = 0.125f * 1.4426950408889634f;
__device__ __forceinline__ void attn_prep_item(int item, bf16_t* P, const float* q_g, const float* k_g, int lane, int wave) {
    const int hd = lane >> 3, j = lane & 7; const bool isq = hd < 6;
    const int col = isq ? PC_AQ + hd * 64 + j * 8 : PC_AK + (hd - 6) * 64 + j * 8;
    const float* gp = (isq ? q_g : k_g) + j * 8;
    float gam[8];
#pragma unroll
    for (int e = 0; e < 8; ++e) gam[e] = gp[e];
    for (int rr = 0; rr < 8; ++rr) {
        const int r = item * 64 + wave * 8 + rr, b = r / ROWB, t = r - b * ROWB; const bool lat = t < SEQL;
        bf16_t* p = P + (size_t)r * PP + col;
        float x[8]; unpack8(*(const u32x4*)p, x);
        float ss = 0.f;
#pragma unroll
        for (int e = 0; e < 8; ++e) ss += x[e] * x[e];
        ss += __shfl_xor(ss, 1); ss += __shfl_xor(ss, 2); ss += __shfl_xor(ss, 4);
        const float rs = 1.0f / sqrtf(ss * (1.0f / 64.0f) + LN_EPS);
#pragma unroll
        for (int e = 0; e < 8; ++e) x[e] = x[e] * rs * gam[e];
        if (lat) {
            const float pos = (float)((j >> 2) ? (t & 63) : (t >> 6)); const bool x2lane = (j & 2) != 0;
#pragma unroll
            for (int e = 0; e < 8; ++e) { const int f = (j & 1) * 8 + e;
                const float inv = exp2f(-(float)f * (13.287712379549449f / 16.0f)), ang = pos * inv, rev = ang * 0.15915494309189535f;
                const float cs = __builtin_amdgcn_cosf(rev), sn = __builtin_amdgcn_sinf(rev);
                const float other = __shfl_xor(x[e], 2);
                x[e] = x[e] * cs + (x2lane ? other : -other) * sn; }
        }
        if (isq) {
#pragma unroll
            for (int e = 0; e < 8; ++e) x[e] *= ATT_C2;
        }
        *(u32x4*)p = pack8(x);
    }
}

__device__ __forceinline__ void dn_chunk_item(int ck, int h, const bf16_t* P, const float* AB, const float* conv_w, const float* a_log, const float* dt_bias,
                                              unsigned char* ws, unsigned char* lds, int tid_in, int lane_in) {
    int tid = tid_in; asm volatile("" : "+v"(tid));
    const int lane = tid & 63;
    float* raw = (float*)lds;
    float* qkv = (float*)(lds + 52224);
    float* KKs = (float*)(lds + 102144);
    float* QKs = (float*)(lds + 118784);
    float* gcs = (float*)(lds + 135424);
    const int r0 = ck * 64, b = r0 / ROWB, t0 = r0 - b * ROWB;
    const int seg_lo = b * ROWB + (t0 < SEQL ? 0 : SEQL), seg_hi = b * ROWB + (t0 < SEQL ? SEQL : ROWB);
    for (int pc = tid; pc < 1632; pc += NTHR) { const int m = pc / 544, rem = pc - m * 544, rr = rem >> 3, ch = rem & 7, row = r0 - 2 + rr;
        float f[8];
#pragma unroll
        for (int e = 0; e < 8; ++e) f[e] = 0.f;
        if (row >= seg_lo && row < seg_hi) unpack8(*(const u32x4*)(P + (size_t)row * PP + PC_DQ + m * 384 + h * 64 + ch * 8), f);
        float* d = raw + (m * 68 + rr) * 64 + ch * 8;
        *(f32x4*)d = (f32x4){f[0], f[1], f[2], f[3]}; *(f32x4*)(d + 4) = (f32x4){f[4], f[5], f[6], f[7]}; }
    __syncthreads();
#pragma unroll 4
    for (int k = 0; k < 24; ++k) { const int idx = tid + NTHR * k, m = idx >> 12, i = (idx >> 6) & 63, d = idx & 63;
        const float* cw = conv_w + m * 384 + h * 64 + d; float s = 0.f;
#pragma unroll
        for (int jj = 0; jj < 5; ++jj) s += cw[jj * 1152] * raw[(m * 68 + i + jj) * 64 + d];
        qkv[(m * 64 + i) * 65 + d] = silu_f(s); }
    __syncthreads();
    { const int row = tid >> 2, part = tid & 3; float* p = qkv + row * 65 + part * 16; float ss = 0.f;
#pragma unroll
        for (int e = 0; e < 16; ++e) ss += p[e] * p[e];
        ss += __shfl_xor(ss, 1); ss += __shfl_xor(ss, 2);
        const float scl = (1.0f / sqrtf(ss + LN_EPS)) * (row < 64 ? 0.125f : 1.0f);
#pragma unroll
        for (int e = 0; e < 16; ++e) p[e] *= scl; }
    __syncthreads();
    unsigned char* shp = ws + WS_DNSH + (size_t)(ck * 6 + h) * 16384;
    { const int rw = tid >> 3, c0 = (tid & 7) * 8; float f[8];
#pragma unroll
        for (int e = 0; e < 8; ++e) f[e] = qkv[rw * 65 + c0 + e];
        *(u32x4*)(shp + (size_t)(rw * 64 + c0) * 2) = pack8(f);
#pragma unroll
        for (int e = 0; e < 8; ++e) f[e] = qkv[(64 + c0 + e) * 65 + rw];
        *(u32x4*)(shp + 8192 + (size_t)(rw * 64 + c0) * 2) = pack8(f); }
    { const int mat = tid >> 8, ib = (tid >> 4) & 15, jb = tid & 15;
        const float* Ap = qkv + ((mat ? 0 : 64) + ib * 4) * 65; const float* Bp = qkv + (64 + jb * 4) * 65;
        float acc[4][4];
#pragma unroll
        for (int ii = 0; ii < 4; ++ii)
#pragma unroll
            for (int jj = 0; jj < 4; ++jj) acc[ii][jj] = 0.f;
#pragma unroll 8
        for (int d = 0; d < 64; ++d) { float av[4], bv[4];
#pragma unroll
            for (int ii = 0; ii < 4; ++ii) { av[ii] = Ap[ii * 65 + d]; bv[ii] = Bp[ii * 65 + d]; }
#pragma unroll
            for (int ii = 0; ii < 4; ++ii)
#pragma unroll
                for (int jj = 0; jj < 4; ++jj) acc[ii][jj] += av[ii] * bv[jj]; }
        float* Op = (mat ? QKs : KKs) + (ib * 4) * 65 + jb * 4;
#pragma unroll
        for (int ii = 0; ii < 4; ++ii)
#pragma unroll
            for (int jj = 0; jj < 4; ++jj) Op[ii * 65 + jj] = acc[ii][jj]; }
    const int dir = tid >> 8, lt = tid & 255;
    if (lt < 64) { const int i = lt, tok = dir ? 63 - i : i; const float* ab = AB + (size_t)(r0 + tok) * 24;
        const float x = ab[dir * 6 + h] + dt_bias[dir * 6 + h];
        const float sp = fmaxf(x, 0.f) + log1pf(expf(-fabsf(x)));
        float g = -expf(a_log[dir * 6 + h]) * sp;
        const float beta = 1.0f / (1.0f + expf(-ab[12 + dir * 6 + h]));
#pragma unroll
        for (int o = 1; o < 64; o <<= 1) { const float tv = __shfl_up(g, o); if (lane >= o) g += tv; }
        gcs[dir * 64 + i] = g; gcs[128 + dir * 64 + i] = beta; }
    __syncthreads();
    float* Ls = raw + dir * 4096;
    const float* gc = gcs + dir * 64; const float* bt = gcs + 128 + dir * 64;
    for (int e = lt; e < 4096; e += 256) { const int i = e >> 6, jx = e & 63, ti = dir ? 63 - i : i, tj = dir ? 63 - jx : jx;
        Ls[e] = (i > jx) ? bt[i] * KKs[ti * 65 + tj] * expf(gc[i] - gc[jx]) : 0.f; }
    __syncthreads();
    const int itd = (ck * 6 + h) * 2 + dir;
    unsigned char* pd = ws + WS_DNPD + (size_t)itd * 24576;
    if (lt < 128) {
        const bool isv = lt < 64; const int cc = lt & 63;
        const float* rp = qkv + (isv ? 128 : 64) * 65 + cc;
        float s[64];
#pragma unroll
        for (int i = 0; i < 64; ++i) { const int ti = dir ? 63 - i : i;
            float acc = rp[ti * 65] * bt[i]; if (!isv) acc *= expf(gc[i]);
#pragma unroll
            for (int jx = 0; jx < i; ++jx) acc -= Ls[i * 64 + jx] * s[jx];
            asm volatile("" : "+v"(acc) :: "memory"); s[i] = acc; }
        if (isv) { bf16_t* uT = (bf16_t*)pd + cc * 64;
#pragma unroll
            for (int q8 = 0; q8 < 8; ++q8) { u32x4 w; w.x = pk2(s[q8 * 8], s[q8 * 8 + 1]); w.y = pk2(s[q8 * 8 + 2], s[q8 * 8 + 3]); w.z = pk2(s[q8 * 8 + 4], s[q8 * 8 + 5]); w.w = pk2(s[q8 * 8 + 6], s[q8 * 8 + 7]);
                *(u32x4*)(uT + q8 * 8) = w; } }
        else { bf16_t* wp = (bf16_t*)(pd + 8192) + cc;
#pragma unroll
            for (int i = 0; i < 64; ++i) wp[i * 64] = (bf16_t)f2bf(s[i]); }
    } else {
        const int q = lt - 128, i = q >> 1, hf = q & 1, ti = dir ? 63 - i : i;
        bf16_t* ip = (bf16_t*)(pd + 16384) + i * 64 + hf * 32;
#pragma unroll
        for (int q8 = 0; q8 < 4; ++q8) { float f[8];
#pragma unroll
            for (int e = 0; e < 8; ++e) { const int jx = hf * 32 + q8 * 8 + e, tj = dir ? 63 - jx : jx; f[e] = (i >= jx) ? QKs[ti * 65 + tj] * expf(gc[i] - gc[jx]) : 0.f; }
            *(u32x4*)(ip + q8 * 8) = pack8(f); }
        float* vec = (float*)(ws + WS_DNVEC) + (size_t)itd * 192;
        if (q < 64) { vec[q] = expf(gc[q]); vec[64 + q] = expf(gc[63] - gc[q]); if (q == 0) vec[128] = expf(gc[63]); }
    }
    __syncthreads();
}

__device__ __forceinline__ void dn_scan_unit(int b, int h, int dir, bf16_t* P, const unsigned char* ws, unsigned char* lds, int tid, int lane, int wave) {
    bf16_t* ST = (bf16_t*)lds;
    bf16_t* vnT = ST + 2 * 4608;
    bf16_t* vnT2 = vnT + 4608;
    for (int i = tid; i < 4 * 4608 / 2; i += NTHR) ((unsigned*)lds)[i] = 0u;
    __syncthreads();
    const int mi = wave >> 1, ni0 = (wave & 1) * 2, lr = lane & 15, lq = lane >> 4;
    f32x4 Sacc[2]; Sacc[0] = (f32x4){0.f, 0.f, 0.f, 0.f}; Sacc[1] = Sacc[0];
    int cur = 0;
    const int rowA = 16 * mi + lr, tokA = dir ? 63 - rowA : rowA, c4 = 16 * mi + lq * 4;
    for (int s = 0; s < 68; ++s) {
        const int ckl = dir ? 67 - s : (s < 4 ? 64 + s : s - 4);
        const int ck = b * 68 + ckl, it = ck * 6 + h, itd = it * 2 + dir;
        const unsigned char* shp = ws + WS_DNSH + (size_t)it * 16384;
        const unsigned char* pd = ws + WS_DNPD + (size_t)itd * 24576;
        const float* vec = (const float*)(ws + WS_DNVEC) + (size_t)itd * 192;
        bf16x8 Aw[2], Aq[2], Ai[2], Ak[2]; u32x2 U[2];
#pragma unroll
        for (int kk = 0; kk < 2; ++kk) {
            Aw[kk] = *(const bf16x8*)(pd + 8192 + (size_t)(rowA * 64 + kk * 32 + lq * 8) * 2);
            Aq[kk] = *(const bf16x8*)(shp + (size_t)(tokA * 64 + kk * 32 + lq * 8) * 2);
            Ai[kk] = *(const bf16x8*)(pd + 16384 + (size_t)(rowA * 64 + kk * 32 + lq * 8) * 2);
            Ak[kk] = *(const bf16x8*)(shp + 8192 + (size_t)(rowA * 64 + kk * 32 + lq * 8) * 2); }
#pragma unroll
        for (int n = 0; n < 2; ++n) U[n] = *(const u32x2*)(pd + (size_t)((16 * (ni0 + n) + lr) * 64 + c4) * 2);
        const f32x4 egc4 = *(const f32x4*)(vec + c4), ekd4 = *(const f32x4*)(vec + 64 + c4); const float egl = vec[128];
        bf16x8 BS[2][2];
#pragma unroll
        for (int n = 0; n < 2; ++n)
#pragma unroll
            for (int kk = 0; kk < 2; ++kk) BS[n][kk] = *(const bf16x8*)(ST + cur * 4608 + (16 * (ni0 + n) + lr) * 72 + kk * 32 + lq * 8);
#pragma unroll
        for (int n = 0; n < 2; ++n) { f32x4 acc = (f32x4){0.f, 0.f, 0.f, 0.f};
            acc = __builtin_amdgcn_mfma_f32_16x16x32_bf16(Aw[0], BS[n][0], acc, 0, 0, 0); acc = __builtin_amdgcn_mfma_f32_16x16x32_bf16(Aw[1], BS[n][1], acc, 0, 0, 0);
            const float v0 = bf2f(U[n].x & 0xffffu) - acc[0], v1 = bf2f(U[n].x >> 16) - acc[1], v2 = bf2f(U[n].y & 0xffffu) - acc[2], v3 = bf2f(U[n].y >> 16) - acc[3];
            const int vrow = (16 * (ni0 + n) + lr) * 72;
            u32x2 w; w.x = pk2(v0, v1); w.y = pk2(v2, v3); *(u32x2*)(vnT + vrow + c4) = w;
            const float s0 = v0 * ekd4[0], s1 = v1 * ekd4[1], s2 = v2 * ekd4[2], s3 = v3 * ekd4[3];
            if (dir == 0) { w.x = pk2(s0, s1); w.y = pk2(s2, s3); *(u32x2*)(vnT2 + vrow + c4) = w; }
            else { w.x = pk2(s3, s2); w.y = pk2(s1, s0); *(u32x2*)(vnT2 + vrow + 60 - c4) = w; } }
        __syncthreads();
        const int r0 = ck * 64, ocol = (dir ? PC_DK : PC_DQ) + h * 64;
#pragma unroll
        for (int n = 0; n < 2; ++n) { f32x4 acc = (f32x4){0.f, 0.f, 0.f, 0.f};
            acc = __builtin_amdgcn_mfma_f32_16x16x32_bf16(Aq[0], BS[n][0], acc, 0, 0, 0); acc = __builtin_amdgcn_mfma_f32_16x16x32_bf16(Aq[1], BS[n][1], acc, 0, 0, 0);
            acc = acc * egc4;
            const int vrow = (16 * (ni0 + n) + lr) * 72;
            const bf16x8 bv0 = *(const bf16x8*)(vnT + vrow + lq * 8), bv1 = *(const bf16x8*)(vnT + vrow + 32 + lq * 8);
            acc = __builtin_amdgcn_mfma_f32_16x16x32_bf16(Ai[0], bv0, acc, 0, 0, 0); acc = __builtin_amdgcn_mfma_f32_16x16x32_bf16(Ai[1], bv1, acc, 0, 0, 0);
#pragma unroll
            for (int jx = 0; jx < 4; ++jx) { const int c = c4 + jx, tok = dir ? 63 - c : c;
                P[(size_t)(r0 + tok) * PP + ocol + 16 * (ni0 + n) + lr] = (bf16_t)f2bf(acc[jx]); }
            const bf16x8 b20 = *(const bf16x8*)(vnT2 + vrow + lq * 8), b21 = *(const bf16x8*)(vnT2 + vrow + 32 + lq * 8);
            f32x4 sa = Sacc[n] * egl;
            sa = __builtin_amdgcn_mfma_f32_16x16x32_bf16(Ak[0], b20, sa, 0, 0, 0); sa = __builtin_amdgcn_mfma_f32_16x16x32_bf16(Ak[1], b21, sa, 0, 0, 0);
            Sacc[n] = sa;
            u32x2 w; w.x = pk2(sa[0], sa[1]); w.y = pk2(sa[2], sa[3]); *(u32x2*)(ST + (cur ^ 1) * 4608 + vrow + c4) = w; }
        cur ^= 1;
        __syncthreads();
    }
}

__device__ __forceinline__ void dn_gate_rows(bf16_t* P, const float* norm_g, int lane, int wave, int G) {
    const int gw = blockIdx.x * NWV + wave, NGW = G * NWV; const float ng = norm_g[lane];
    for (int r = gw; r < NROW; r += NGW) { bf16_t* pr = P + (size_t)r * PP;
#pragma unroll
        for (int h = 0; h < 6; ++h) { const float o = bf2f(pr[PC_DQ + h * 64 + lane]) + bf2f(pr[PC_DK + h * 64 + lane]);
            const float ss = wave_sum(o * o); const float z = bf2f(pr[PC_Z + h * 64 + lane]);
            pr[PC_Z + h * 64 + lane] = (bf16_t)f2bf(o * (1.0f / sqrtf(ss * (1.0f / 64.0f) + LN_EPS)) * ng * silu_f(z)); } }
}

#ifndef EN_G1
#define EN_G1 1
#endif
#ifndef EN_G2
#define EN_G2 1
#endif
#ifndef EN_G3
#define EN_G3 1
#endif
#ifndef EN_G4
#define EN_G4 1
#endif
#ifndef EN_PRO
#define EN_PRO 1
#endif
#ifndef EN_GEMM
#define EN_GEMM 1
#endif
#ifndef EN_GMLP
#define EN_GMLP 1
#endif
#ifndef EN_DNC
#define EN_DNC 1
#endif
#ifndef EN_PREP
#define EN_PREP 1
#endif
#ifndef EN_SCAN
#define EN_SCAN 1
#endif
#ifndef EN_ATTN
#define EN_ATTN 1
#endif
#ifndef EN_GATE
#define EN_GATE 1
#endif
#ifndef EN_LN
#define EN_LN 1
#endif
constexpr int LDS_BYTES = 147456;
#define FRESH() do { tid = threadIdx.x; asm volatile("" : "+v"(tid)); lane = tid & 63; wave = __builtin_amdgcn_readfirstlane(tid >> 6); } while (0)
#define FRESHL() do { asm volatile("" : "+s"(l)); wb = ws + WS_W + (size_t)l * W_LAYER; mv = modv + (size_t)l * 5 * MODW; xlat = l == 0 ? a.in[0] : a.out; xctx = l == 0 ? a.in[2] : Xctx; } while (0)
template <int LYR> __device__ __forceinline__ void layer_fwd(const Args& a, unsigned char* lds, cg::grid_group& grid) {
    int tid = threadIdx.x, lane = tid & 63, wave = __builtin_amdgcn_readfirstlane(tid >> 6); const int G = gridDim.x;
    unsigned char* ws = a.ws;
    bf16_t* P = (bf16_t*)(ws + WS_P); bf16_t* XN = (bf16_t*)(ws + WS_XN); bf16_t* H = (bf16_t*)(ws + WS_H);
    float* AB = (float*)(ws + WS_AB); float* Xctx = (float*)(ws + WS_XCTX); float* modv = (float*)(ws + WS_MODV);
    PG8_LAS unsigned char* lds3 = (PG8_LAS unsigned char*)lds;
    int l = LYR;
        const unsigned char* wb; const float* mv; const float* xlat; const float* xctx;
        FRESHL();
        { pg8::Gemm g{XN, (const bf16_t*)(wb + W_IN_OFF), NROW, 2816, 1024, 1024}; pg8::StaticOrder S; S.init(NROW, 2816, G, (int)blockIdx.x);
          pg8::EpiP E{P, AB}; if (EN_GEMM && EN_G1) pg8::gemm_phase<pg8::EpiP, pg8::StaticOrder, true, true>(lds3, g, S, E); }
        grid.sync();
        FRESHL();
        for (int it = blockIdx.x; it < 136 + 1632 + 272; it += G) { FRESH();
            if (it < 136) { if (EN_GMLP) gmlp_item(it, P, a.in[8] + l * 256, a.in[9] + l * 256, a.in[10] + (size_t)l * 4 * 128 * 128, a.in[11] + l * 512, lds, tid, lane, wave); }
            else if (it < 136 + 1632) { const int q = it - 136; if (EN_DNC) dn_chunk_item(q / 6, q % 6, P, AB, a.in[14] + (size_t)l * 5 * 1152, a.in[15] + l * 12, a.in[16] + l * 12, ws, lds, tid, lane); }
            else if (EN_PREP) attn_prep_item(it - 136 - 1632, P, a.in[12] + l * 64, a.in[13] + l * 64, lane, wave);
        }
        grid.sync();
        FRESHL();
        FRESH();
        if (blockIdx.x < 48) { const int u = blockIdx.x; if (EN_SCAN) dn_scan_unit(u / 12, (u % 12) >> 1, u & 1, P, ws, lds, tid, lane, wave); }
        else {
            const int nat = (l == 0) ? 408 : 384;
            if (EN_ATTN) for (int u = blockIdx.x - 48; u < nat; u += G - 48) {
                const attn_body::bf16* Pb = (const attn_body::bf16*)P;
                if (u < 384) { const int b = u / 96, rem = u - b * 96, hq = rem >> 4, qb = rem & 15; const size_t rb = (size_t)b * ROWB;
                    attn_body::attn_unit<8>(Pb + (rb + qb * 256) * PP + PC_AQ + hq * 64, Pb + rb * PP + PC_AK + (hq / 3) * 64, Pb + rb * PP + PC_AV + (hq / 3) * 64,
                                            (attn_body::bf16*)P + (rb + qb * 256) * PP + PC_AQ + hq * 64, 68, (char*)lds); }
                else { const int v = u - 384, b = v / 6, hq = v - b * 6; const size_t rb = (size_t)b * ROWB + SEQL;
                    attn_body::attn_unit<8>(Pb + rb * PP + PC_AQ + hq * 64, Pb + rb * PP + PC_AK + (hq / 3) * 64, Pb + rb * PP + PC_AV + (hq / 3) * 64,
                                            (attn_body::bf16*)P + rb * PP + PC_AQ + hq * 64, 4, (char*)lds); }
            }
        }
        grid.sync();
        FRESHL();
        FRESH(); if (EN_GATE) dn_gate_rows(P, a.in[17] + l * 64, lane, wave, G);
        grid.sync();
        FRESHL();
        { pg8::Gemm g{P, (const bf16_t*)(wb + W_OUT_OFF), NROW, 1024, 1024, PP}; pg8::StaticOrder S; S.init(NROW, 1024, G, (int)blockIdx.x);
          pg8::EpiRes E{xlat, xctx, a.out, Xctx, mv + 2 * 1024}; if (EN_GEMM && EN_G2) pg8::gemm_phase<pg8::EpiRes, pg8::StaticOrder, true, true>(lds3, g, S, E); }
        grid.sync();
        FRESHL();
        FRESH(); if (EN_LN) ln_rows<1>(a.out, Xctx, a.out, Xctx, a.in[18] + l * 1024, a.in[19] + l * 1024, mv + 3 * 1024, XN, true, false, lane, wave, G);
        grid.sync();
        FRESHL();
        { pg8::Gemm g{XN, (const bf16_t*)(wb + W_UP_OFF), NROW, DFF, 1024, 1024}; pg8::StaticOrder S; S.init(NROW, DFF, G, (int)blockIdx.x);
          pg8::EpiH E{H}; if (EN_GEMM && EN_G3) pg8::gemm_phase<pg8::EpiH, pg8::StaticOrder, true, true>(lds3, g, S, E); }
        grid.sync();
        FRESHL();
        { pg8::Gemm g{H, (const bf16_t*)(wb + W_DN_OFF), NROW, 1024, DFF, DFF}; pg8::StaticOrder S; S.init(NROW, 1024, G, (int)blockIdx.x);
          pg8::EpiRes E{a.out, Xctx, a.out, Xctx, mv + 5 * 1024}; if (EN_GEMM && EN_G4) pg8::gemm_phase<pg8::EpiRes, pg8::StaticOrder, true, true>(lds3, g, S, E); }
        grid.sync();
        FRESHL();
        FRESH(); if (EN_LN) ln_rows<1>(a.out, Xctx, a.out, Xctx, a.in[20] + l * 1024, a.in[21] + l * 1024, modv + (size_t)(l + 1) * 5 * MODW, XN, l + 1 < NLAYER, l + 1 == NLAYER, lane, wave, G);
        if (l + 1 < NLAYER) grid.sync();
}

__global__ void __launch_bounds__(NTHR, 2) mega_fwd(Args a) {
    extern __shared__ __attribute__((aligned(16))) unsigned char lds[];
    cg::grid_group grid = cg::this_grid();
    {
        int tid = threadIdx.x, lane = tid & 63, wave = __builtin_amdgcn_readfirstlane(tid >> 6); const int G = gridDim.x;
        unsigned char* ws = a.ws;
        bf16_t* P = (bf16_t*)(ws + WS_P); bf16_t* XN = (bf16_t*)(ws + WS_XN); bf16_t* H = (bf16_t*)(ws + WS_H);
        float* AB = (float*)(ws + WS_AB); float* Xctx = (float*)(ws + WS_XCTX); float* modv = (float*)(ws + WS_MODV);
        PG8_LAS unsigned char* lds3 = (PG8_LAS unsigned char*)lds;
#if EN_PRO
        FRESH(); phase_prologue(a, lds, tid, lane, wave, G);
#endif
        grid.sync();
        FRESH(); if (EN_LN) ln_rows<0>(a.in[0], a.in[2], nullptr, nullptr, nullptr, nullptr, modv, XN, true, false, lane, wave, G);
        grid.sync();
    }
    layer_fwd<0>(a, lds, grid);
    layer_fwd<1>(a, lds, grid);
}

extern "C" void kernel_launch(void* const* d_in, const int* in_sizes, int n_in, void* d_out, int out_size, void* d_ws, size_t ws_size, hipStream_t stream) {
    static int grid = 0;
    if (grid == 0) {
        int dev = 0, cus = 0, per_cu = 0;
        hipGetDevice(&dev);
        hipDeviceGetAttribute(&cus, hipDeviceAttributeMultiprocessorCount, dev);
        if (hipFuncSetAttribute((const void*)mega_fwd, hipFuncAttributeMaxDynamicSharedMemorySize, LDS_BYTES) != hipSuccess) fprintf(stderr, "kernel_launch: hipFuncSetAttribute failed\n");
        if (hipOccupancyMaxActiveBlocksPerMultiprocessor(&per_cu, (const void*)mega_fwd, NTHR, LDS_BYTES) != hipSuccess || per_cu < 1) { fprintf(stderr, "kernel_launch: occupancy query says %d\n", per_cu); per_cu = 1; }
        (void)hipGetLastError();
        grid = cus * 1;
        if (n_in != 24 || ws_size < 254 * MiB) fprintf(stderr, "kernel_launch: unexpected n_in %d / ws %zu\n", n_in, ws_size);
    }
    Args a{};
    for (int i = 0; i < 24; ++i) a.in[i] = (const float*)d_in[i];
    a.out = (float*)d_out; a.ws = (unsigned char*)d_ws;
    void* params[] = {&a};
    hipError_t e = hipLaunchCooperativeKernel((const void*)mega_fwd, dim3(grid), dim3(NTHR), params, LDS_BYTES, stream);
    if (e != hipSuccess) fprintf(stderr, "kernel_launch: cooperative launch failed: %s (grid %d)\n", hipGetErrorString(e), grid);
}
```

```cpp
#include <hip/hip_runtime.h>
#include <hip/hip_cooperative_groups.h>
#include <cstdio>
#include <cstdint>
namespace cg = cooperative_groups;
namespace pg8 {
#define PG8_LAS __attribute__((address_space(3)))
typedef unsigned short bf16_t;
typedef short bf16x8 __attribute__((ext_vector_type(8)));
typedef float f32x4 __attribute__((ext_vector_type(4)));
typedef unsigned u32x4 __attribute__((ext_vector_type(4)));
constexpr int BM = 256, BK = 64, HALF = 128, HTB = HALF * BK * 2  , STAGE_BYTES = 8 * HTB, NXCD = 8, WGM = 8;

__host__ __device__ __forceinline__ int lds_byte(int r, int c) { const int st = (r >> 4) * 2 + (c >> 5), rr = r & 15, cc = c & 31, ob = rr * 64 + cc * 2; return st * 1024 + (ob ^ (((ob >> 9) & 1) << 5)); }
__host__ __device__ __forceinline__ void stage_rc(int b, int& R, int& C) { const int st = b / 1024, sb = b % 1024, swz = sb ^ (((sb >> 9) & 1) << 5); R = (st >> 1) * 16 + swz / 64; C = (st & 1) * 32 + (swz % 64) / 2; }
__host__ __device__ __forceinline__ int perm32(int rho) { const int n = rho >> 4, i = rho & 15; return 8 * (i >> 2) + 4 * n + (i & 3); }

struct Unit { int pm, pn; };
struct Gemm { const bf16_t* A; const bf16_t* Bt; int M, N, K, lda, amap; };

struct StaticOrder {
    int nM, nN, nwg, G, c;
    __host__ __device__ void init(int M, int N, int G_, int c_) { nM = M / BM; nN = N / BM; nwg = nM * nN; G = G_; c = c_; }
    __host__ __device__ bool next(int i, Unit& u) const {
        const long L = (long)i * G + c; if (L >= nwg) return false;
        int wgid = (int)L; { const int q = nwg / NXCD, r = nwg % NXCD, xcd = wgid % NXCD, off = wgid / NXCD; wgid = (xcd < r ? xcd * (q + 1) : r * (q + 1) + (xcd - r) * q) + off; }
        const int nig = WGM * nN, gid = wgid / nig, fm = gid * WGM, gsz = (nM - fm) < WGM ? (nM - fm) : WGM;
        u.pm = fm + ((wgid % nig) % gsz); u.pn = (wgid % nig) / gsz; return true;
    }
    __device__ __forceinline__ void a_ready(const Unit&) const {}
    __device__ __forceinline__ void done(const Unit&) const {}
};

__device__ __forceinline__ unsigned cvt_pk_bf16(float lo, float hi) { unsigned r; asm volatile("v_cvt_pk_bf16_f32 %0, %1, %2" : "=v"(r) : "v"(lo), "v"(hi)); return r; }
template <class Epi, class Sched, bool ALIGN_EPI = false, bool SP2 = false>
__device__ __forceinline__ void gemm_phase(PG8_LAS unsigned char* lds, const Gemm g, const Sched& S, const Epi& E) {
    int tid_ = threadIdx.x; asm volatile("" : "+v"(tid_)); const int tid = tid_, wid = __builtin_amdgcn_readfirstlane(tid >> 6), lane = tid & 63, wr = wid >> 2, wc = wid & 3, fr = lane & 15, fq = lane >> 4;
    const int K = g.K, nt = K / BK;
    unsigned voffA[2], voffB[2];
#pragma unroll
    for (int i = 0; i < 2; ++i) { int R, C; stage_rc(tid * 16 + i * 8192, R, C); const int Rb = Epi::PERM ? ((R & ~31) + perm32(R & 31)) : R;
        voffA[i] = (unsigned)(R * g.lda + C) * 2u; voffB[i] = (unsigned)(Rb * K + C) * 2u; }
    const size_t kstep = (size_t)(BK * 2);
    const size_t hstepA = (size_t)HALF * g.lda * 2, hstepB = (size_t)HALF * K * 2;
    const size_t tstepA = 2 * hstepA, tstepB = 2 * hstepB;
    const unsigned ldsw = (unsigned)wid * 1024u;
    const int aoff = lds_byte(wr * 64 + fr, fq * 8), boff = lds_byte(wc * 32 + fr, fq * 8);
#define PG8_SA(b, h) (((b) * 2 + (h)) * HTB)
#define PG8_SB(b, h) ((4 + (b) * 2 + (h)) * HTB)
#define PG8_STAGE(bufoff, gbase, voff) do { _Pragma("unroll") for (int _i = 0; _i < 2; ++_i) \
        __builtin_amdgcn_global_load_lds((const unsigned*)((const char*)(gbase) + (voff)[_i]), (PG8_LAS unsigned*)(lds + (bufoff) + ldsw + _i * 8192), 16, 0, 0); } while (0)
#define PG8_LDA(dst, b, h) do { _Pragma("unroll") for (int m = 0; m < 4; ++m) _Pragma("unroll") for (int k = 0; k < 2; ++k) dst[m][k] = *(const PG8_LAS bf16x8*)(lds + PG8_SA(b, h) + aoff + m * 2048 + k * 1024); } while (0)
#define PG8_LDB(dst, b, h) do { _Pragma("unroll") for (int n = 0; n < 2; ++n) _Pragma("unroll") for (int k = 0; k < 2; ++k) dst[n][k] = *(const PG8_LAS bf16x8*)(lds + PG8_SB(b, h) + boff + n * 2048 + k * 1024); } while (0)
#define PG8_MMA(ai, bj, At, Bt) do { __builtin_amdgcn_s_setprio(1); _Pragma("unroll") for (int m = 0; m < 4; ++m) _Pragma("unroll") for (int n = 0; n < 2; ++n) _Pragma("unroll") for (int k = 0; k < 2; ++k) \
        acc[ai][bj][m][n] = __builtin_amdgcn_mfma_f32_16x16x32_bf16(Bt[n][k], At[m][k], acc[ai][bj][m][n], 0, 0, 0); __builtin_amdgcn_s_setprio(0); } while (0)
#define PG8_WAIT_V(n) asm volatile("s_waitcnt vmcnt(" #n ")" ::: "memory")
#define PG8_WAIT_L(n) asm volatile("s_waitcnt lgkmcnt(" #n ")" ::: "memory")
#define PG8_BAR __builtin_amdgcn_s_barrier()
#define PG8_SCHED __builtin_amdgcn_sched_barrier(0)
    Unit cur, nxt; int ui = 0;
    if (!S.next(0, cur)) return;
    f32x4 acc[2][2][4][2];
#pragma unroll
    for (int a = 0; a < 2; ++a)
#pragma unroll
        for (int b = 0; b < 2; ++b)
#pragma unroll
            for (int m = 0; m < 4; ++m)
#pragma unroll
                for (int n = 0; n < 2; ++n) acc[a][b][m][n] = (f32x4){0.f, 0.f, 0.f, 0.f};
    bf16x8 At[4][2], B0[2][2], B1[2][2];
    const char* cA = (const char*)g.A + (size_t)(g.amap ? cur.pm + (cur.pm >> 4) : cur.pm) * tstepA; const char* cB = (const char*)g.Bt + (size_t)cur.pn * tstepB;
    S.a_ready(cur);
    if constexpr (SP2) {
        PG8_STAGE(PG8_SB(0, 0), cB, voffB); PG8_STAGE(PG8_SB(0, 1), cB + hstepB, voffB); PG8_STAGE(PG8_SA(0, 0), cA, voffA); PG8_STAGE(PG8_SA(0, 1), cA + hstepA, voffA);
        if (wr == 1) PG8_BAR;
        PG8_WAIT_V(2); PG8_BAR;
        PG8_STAGE(PG8_SB(1, 0), cB + kstep, voffB); PG8_STAGE(PG8_SA(1, 0), cA + kstep, voffA); PG8_STAGE(PG8_SB(1, 1), cB + hstepB + kstep, voffB);
        PG8_WAIT_V(6); PG8_BAR;
    } else {
        PG8_STAGE(PG8_SB(0, 0), cB, voffB); PG8_STAGE(PG8_SA(0, 0), cA, voffA); PG8_STAGE(PG8_SB(0, 1), cB + hstepB, voffB); PG8_STAGE(PG8_SA(0, 1), cA + hstepA, voffA);
        if (wr == 1) PG8_BAR;
        PG8_WAIT_V(4); PG8_BAR;
        PG8_STAGE(PG8_SB(1, 0), cB + kstep, voffB); PG8_STAGE(PG8_SA(1, 0), cA + kstep, voffA); PG8_STAGE(PG8_SB(1, 1), cB + hstepB + kstep, voffB);
        PG8_WAIT_V(6); PG8_BAR;
    }
    for (;;) {
        const bool has_next = S.next(ui + 1, nxt);
        const char* nA = has_next ? (const char*)g.A + (size_t)(g.amap ? nxt.pm + (nxt.pm >> 4) : nxt.pm) * tstepA : cA; const char* nB = has_next ? (const char*)g.Bt + (size_t)nxt.pn * tstepB : cB;
        for (int t = 0; t < nt; t += 2) {
            const bool last = (t == nt - 2);
            const char* a1 = cA + (size_t)(t + 1) * kstep;
            const char* a2 = last ? nA : cA + (size_t)(t + 2) * kstep; const char* b2 = last ? nB : cB + (size_t)(t + 2) * kstep;
            const char* a3 = a2 + kstep; const char* b3 = b2 + kstep;
            if (last && has_next) S.a_ready(nxt);
            if constexpr (SP2) {
            PG8_LDB(B0, 0, 0); PG8_LDB(B1, 0, 1); PG8_SCHED; PG8_LDA(At, 0, 0); PG8_STAGE(PG8_SA(1, 1), a1 + hstepA, voffA);
            PG8_WAIT_V(8); PG8_WAIT_L(0); PG8_BAR; PG8_MMA(0, 0, At, B0); PG8_MMA(0, 1, At, B1); PG8_BAR; PG8_SCHED;
            PG8_LDA(At, 0, 1); PG8_STAGE(PG8_SB(0, 0), b2, voffB); PG8_STAGE(PG8_SB(0, 1), b2 + hstepB, voffB); PG8_STAGE(PG8_SA(0, 0), a2, voffA);
            PG8_WAIT_V(8); PG8_WAIT_L(0); PG8_BAR; PG8_MMA(1, 0, At, B0); PG8_MMA(1, 1, At, B1); PG8_BAR; PG8_SCHED;
            PG8_LDB(B0, 1, 0); PG8_LDB(B1, 1, 1); PG8_SCHED; PG8_LDA(At, 1, 0); PG8_STAGE(PG8_SA(0, 1), a2 + hstepA, voffA);
            PG8_WAIT_V(8); PG8_WAIT_L(0); PG8_BAR; PG8_MMA(0, 0, At, B0); PG8_MMA(0, 1, At, B1); PG8_BAR; PG8_SCHED;
            PG8_LDA(At, 1, 1); PG8_STAGE(PG8_SB(1, 0), b3, voffB); PG8_STAGE(PG8_SB(1, 1), b3 + hstepB, voffB); PG8_STAGE(PG8_SA(1, 0), a3, voffA);
            PG8_WAIT_V(8); PG8_WAIT_L(0); PG8_BAR; PG8_MMA(1, 0, At, B0); PG8_MMA(1, 1, At, B1); PG8_BAR; PG8_SCHED;
            } else {
            PG8_LDB(B0, 0, 0); PG8_SCHED; PG8_LDA(At, 0, 0); PG8_STAGE(PG8_SA(1, 1), a1 + hstepA, voffA);
            PG8_WAIT_L(8); PG8_BAR; PG8_WAIT_L(0); PG8_MMA(0, 0, At, B0); PG8_BAR; PG8_SCHED;
            PG8_LDB(B1, 0, 1); PG8_STAGE(PG8_SB(0, 0), b2, voffB);
            PG8_BAR; PG8_WAIT_L(0); PG8_MMA(0, 1, At, B1); PG8_BAR;
            PG8_LDA(At, 0, 1); PG8_STAGE(PG8_SA(0, 0), a2, voffA);
            PG8_BAR; PG8_WAIT_L(0); PG8_MMA(1, 0, At, B0); PG8_BAR; PG8_SCHED;
            PG8_STAGE(PG8_SB(0, 1), b2 + hstepB, voffB);
            PG8_WAIT_V(6); PG8_BAR; PG8_MMA(1, 1, At, B1); PG8_BAR;
            PG8_LDB(B0, 1, 0); PG8_SCHED; PG8_LDA(At, 1, 0); PG8_STAGE(PG8_SA(0, 1), a2 + hstepA, voffA);
            PG8_WAIT_L(8); PG8_BAR; PG8_WAIT_L(0); PG8_MMA(0, 0, At, B0); PG8_BAR; PG8_SCHED;
            PG8_LDB(B1, 1, 1); PG8_STAGE(PG8_SB(1, 0), b3, voffB);
            PG8_BAR; PG8_WAIT_L(0); PG8_MMA(0, 1, At, B1); PG8_BAR;
            PG8_LDA(At, 1, 1); PG8_STAGE(PG8_SA(1, 0), a3, voffA);
            PG8_BAR; PG8_WAIT_L(0); PG8_MMA(1, 0, At, B0); PG8_BAR; PG8_SCHED;
            PG8_STAGE(PG8_SB(1, 1), b3 + hstepB, voffB);
            PG8_WAIT_V(6); PG8_BAR; PG8_MMA(1, 1, At, B1); PG8_BAR;
            }
        }
        if constexpr (ALIGN_EPI) { if (wr == 0) PG8_BAR; }
        if constexpr (!Epi::AFTER_DRAIN) { E(acc, cur, wr, wc, fr, fq); S.done(cur); }
        if (!has_next) break;
#pragma unroll
        for (int a = 0; a < 2; ++a)
#pragma unroll
            for (int b = 0; b < 2; ++b)
#pragma unroll
                for (int m = 0; m < 4; ++m)
#pragma unroll
                    for (int n = 0; n < 2; ++n) acc[a][b][m][n] = (f32x4){0.f, 0.f, 0.f, 0.f};
        cur = nxt; cA = nA; cB = nB; ++ui;
        if constexpr (ALIGN_EPI) { if (wr == 1) PG8_BAR; }
    }
    PG8_WAIT_V(0);
    if constexpr (!ALIGN_EPI) { if (wr == 0) PG8_BAR; }
    PG8_BAR;
    if constexpr (Epi::AFTER_DRAIN) { E.fused(acc, cur, wr, wc, fr, fq, lds, wid, lane); S.done(cur); }
#undef PG8_SA
#undef PG8_SB
#undef PG8_STAGE
#undef PG8_LDA
#undef PG8_LDB
#undef PG8_MMA
#undef PG8_WAIT_V
#undef PG8_WAIT_L
#undef PG8_BAR
#undef PG8_SCHED
}
}
#include <hip/hip_bf16.h>
#include <cmath>
namespace attn_body {
using bf16=__hip_bfloat16;
using bf16x8=__attribute__((ext_vector_type(8)))short;
using s16x4=__attribute__((ext_vector_type(4)))short;
using f32x16=__attribute__((ext_vector_type(16)))float;
using u32x4=__attribute__((ext_vector_type(4)))unsigned;
constexpr int D=64,DM=2816;
constexpr int NW=8,QBLK=32,QB=QBLK*NW,KVBLK=64;
constexpr int ATTN_PITCH=DM, ATTN_UNIT_ROWS=QB;
__device__ __forceinline__ int crow(int r,int hi){return (r&3)+8*(r>>2)+4*hi;}
#define SBAR() __builtin_amdgcn_sched_barrier(0)
__device__ __forceinline__ void cmask(f32x16&p0,f32x16&p1,int jb,int qrel,int hi){
  const float NEG=-INFINITY; int kb=64*jb+4*hi;
  #pragma unroll
  for(int r=0;r<16;++r){int kv=kb+(r&3)+8*(r>>2); if(kv>qrel)p0[r]=NEG; if(kv+32>qrel)p1[r]=NEG;}
}

constexpr int NSLOT=3, SLOTB=8192;
constexpr int LDS_K=0, LDS_V=NSLOT*SLOTB, LDS_WS=2*NSLOT*SLOTB, LDS_OST=LDS_WS+NW*64*4, LDS_BYTES=LDS_OST+NW*4096;
constexpr float C2=0.125f*1.4426950408889634f;
__device__ __forceinline__ void glds16(const void*gsrc,unsigned lds_dst){unsigned keep;
  asm volatile("s_mov_b32 %0, m0\n\ts_mov_b32 m0, %2\n\ts_nop 0\n\tglobal_load_lds_dwordx4 %1, off\n\ts_mov_b32 m0, %0":"=&s"(keep):"v"(gsrc),"s"(lds_dst):"memory");}
__device__ __forceinline__ float max3f(float a,float b,float c){float r;asm("v_max3_f32 %0, %1, %2, %3":"=v"(r):"v"(a),"v"(b),"v"(c));return r;}
__device__ __forceinline__ float max2f(float a,float b){float r;asm("v_max_f32_e32 %0, %1, %2":"=v"(r):"v"(a),"v"(b));return r;}
__device__ __forceinline__ float fadd_s(float a,float b){float r;asm("v_add_f32_e32 %0, %1, %2":"=v"(r):"v"(a),"v"(b));return r;}
__device__ __forceinline__ float fsub_s(float a,float b){float r;asm("v_sub_f32_e32 %0, %1, %2":"=v"(r):"v"(a),"v"(b));return r;}
typedef float f32x2_t __attribute__((ext_vector_type(2))); typedef __bf16 bf16x2_t __attribute__((ext_vector_type(2)));
__device__ __forceinline__ unsigned cvtpk_s(float lo,float hi){f32x2_t v={lo,hi};bf16x2_t b=__builtin_convertvector(v,bf16x2_t);return __builtin_bit_cast(unsigned,b);}
#define WAIT_BAR(N) asm volatile("s_waitcnt vmcnt(" #N ") lgkmcnt(0)\n\ts_barrier":::"memory")

__device__ __forceinline__ void qkt(f32x16&p0,f32x16&p1,const char*Kslot,const bf16x8*qr,const f32x16&negm,int r32,int hi){
  const char*kb=Kslot+hi*1024+r32*16;
  #pragma unroll
  for(int d0=0;d0<4;++d0){
    const bf16x8 b0=*reinterpret_cast<const bf16x8*>(kb+d0*2048);
    const bf16x8 b1=*reinterpret_cast<const bf16x8*>(kb+d0*2048+512);
    if(d0==0){p0=__builtin_amdgcn_mfma_f32_32x32x16_bf16(b0,qr[0],negm,0,0,0);p1=__builtin_amdgcn_mfma_f32_32x32x16_bf16(b1,qr[0],negm,0,0,0);}
    else{p0=__builtin_amdgcn_mfma_f32_32x32x16_bf16(b0,qr[d0],p0,0,0,0);p1=__builtin_amdgcn_mfma_f32_32x32x16_bf16(b1,qr[d0],p1,0,0,0);}}
}
typedef __attribute__((address_space(3))) const char* lds_cptr;
typedef short v4i16_t __attribute__((ext_vector_type(4)));
__device__ __forceinline__ void kload8(bf16x8*kf,lds_cptr kp){
  kf[0]=*(const __attribute__((address_space(3))) bf16x8*)(kp);      kf[1]=*(const __attribute__((address_space(3))) bf16x8*)(kp+512);
  kf[2]=*(const __attribute__((address_space(3))) bf16x8*)(kp+2048); kf[3]=*(const __attribute__((address_space(3))) bf16x8*)(kp+2560);
  kf[4]=*(const __attribute__((address_space(3))) bf16x8*)(kp+4096); kf[5]=*(const __attribute__((address_space(3))) bf16x8*)(kp+4608);
  kf[6]=*(const __attribute__((address_space(3))) bf16x8*)(kp+6144); kf[7]=*(const __attribute__((address_space(3))) bf16x8*)(kp+6656);
}
__device__ __forceinline__ void kload2(bf16x8*kf,lds_cptr kp,int j){ kf[2*j]=*(const __attribute__((address_space(3))) bf16x8*)(kp+j*2048); kf[2*j+1]=*(const __attribute__((address_space(3))) bf16x8*)(kp+j*2048+512); }
__device__ __forceinline__ s16x4 vtr(lds_cptr p){ return __builtin_bit_cast(s16x4,__builtin_amdgcn_ds_read_tr16_b64_v4i16((__attribute__((address_space(3))) v4i16_t*)p)); }
__device__ __forceinline__ float rowmax(const f32x16&p0,const f32x16&p1){
  float a=max3f(p0[0],p0[1],p1[0]),b=max3f(p0[2],p0[3],p1[1]);a=max3f(a,p1[2],p1[3]);
  #pragma unroll
  for(int r=4;r<16;r+=4){a=max3f(a,p0[r],p0[r+1]);b=max3f(b,p0[r+2],p0[r+3]);a=max3f(a,p1[r],p1[r+1]);b=max3f(b,p1[r+2],p1[r+3]);}
  const float m=max2f(a,b);
  auto rr=__builtin_amdgcn_permlane32_swap(__float_as_uint(m),__float_as_uint(m),false,false);
  return max2f(__uint_as_float(rr[0]),__uint_as_float(rr[1]));
}
__device__ __forceinline__ void pv(f32x16*o,int vb,bf16x8 pa0,bf16x8 pa1,bf16x8 pa2,bf16x8 pa3){
  #pragma unroll
  for(int d0=0;d0<2;++d0){s16x4 lo[4],hi[4];
    #pragma unroll
    for(int ks=0;ks<4;++ks){
      asm volatile("ds_read_b64_tr_b16 %0,%1 offset:%c2":"=&v"(lo[ks]):"v"(vb),"i"(d0*4096+ks*1024):"memory");
      asm volatile("ds_read_b64_tr_b16 %0,%1 offset:%c2":"=&v"(hi[ks]):"v"(vb),"i"(d0*4096+ks*1024+512):"memory");}
    asm volatile("s_waitcnt lgkmcnt(0)":::"memory");SBAR();
    #define PK(k) (bf16x8){lo[k][0],lo[k][1],lo[k][2],lo[k][3],hi[k][0],hi[k][1],hi[k][2],hi[k][3]}
    o[d0]=__builtin_amdgcn_mfma_f32_32x32x16_bf16(pa0,PK(0),o[d0],0,0,0);
    o[d0]=__builtin_amdgcn_mfma_f32_32x32x16_bf16(pa1,PK(1),o[d0],0,0,0);
    o[d0]=__builtin_amdgcn_mfma_f32_32x32x16_bf16(pa2,PK(2),o[d0],0,0,0);
    o[d0]=__builtin_amdgcn_mfma_f32_32x32x16_bf16(pa3,PK(3),o[d0],0,0,0);
    #undef PK
  }
}

#ifndef ATTN_STORE16
#define ATTN_STORE16(p,v) (*(u32x4*)(p)=(v))
#endif
template<int THRL> __device__ __forceinline__ void attn_unit(const bf16*Qb,const bf16*Kh,const bf16*Vh,bf16*Ob,const int NT,char*shm){
  int tid_=threadIdx.x; asm volatile("":"+v"(tid_)); const int tid=tid_,lane=tid&63,r32=lane&31,hi=lane>>5; const int wid=__builtin_amdgcn_readfirstlane(tid>>6);
  const bf16*Qw=Qb+(long)(wid*QBLK)*DM;
  const unsigned lds0=(unsigned)(uintptr_t)shm;
  float*wsf=(float*)(shm+LDS_WS)+wid*64;
  const bf16*ksrc=Kh+(long)lane*DM+wid*8;
  const bf16*vsrc=Vh+(long)(16*(wid&3)+(lane>>2))*DM+(wid>>2)*32+(lane&3)*8;
  const unsigned kdst=lds0+LDS_K+wid*1024, vdst=lds0+LDS_V+wid*1024;
  #define DMA_K(t,slot) glds16(ksrc+(long)(t)*KVBLK*DM,(unsigned)__builtin_amdgcn_readfirstlane(kdst+(slot)))
  #define DMA_V(t,slot) glds16(vsrc+(long)(t)*KVBLK*DM,(unsigned)__builtin_amdgcn_readfirstlane(vdst+(slot)))
  const int vb0=(int)(lds0+LDS_V)+((lane>>4)&1)*32+(lane&3)*8+(4*hi+((lane&15)>>2))*64;
  const char*Kbase=shm+LDS_K; bf16x8 kf[8];
  const lds_cptr shm3=(lds_cptr)shm; const lds_cptr kp0=shm3+LDS_K+hi*1024+r32*16; const lds_cptr vp0=shm3+LDS_V+((lane>>4)&1)*32+(lane&3)*8+(4*hi+((lane&15)>>2))*64;
  DMA_K(0,0);DMA_V(0,0);DMA_K(1,SLOTB);
  bf16x8 qr[4];
  #pragma unroll
  for(int d0=0;d0<4;++d0)qr[d0]=*reinterpret_cast<const bf16x8*>(&Qw[(long)r32*DM+d0*16+hi*8]);
  float mhat=0.f,l_reg=0.f;f32x16 o[2];o[0]=f32x16{};o[1]=f32x16{};f32x16 negm=f32x16{};asm volatile("":"+v"(negm));
  #define CMASK(P0,P1,t) do{}while(0)
  bool resc=false;
  #define START(P0,P1) do{ const float rm=rowmax(P0,P1); resc=false; \
    { const float dl=rm; mhat=fadd_s(mhat,dl); \
      _Pragma("unroll") for(int r=0;r<16;++r){P0[r]=fsub_s(P0[r],dl);P1[r]=fsub_s(P1[r],dl);} \
      _Pragma("unroll") for(int r=0;r<16;++r)negm[r]=-mhat; asm volatile("":"+v"(negm)); } \
    _Pragma("unroll") for(int r=0;r<16;++r)P0[r]=__builtin_amdgcn_exp2f(P0[r]); }while(0)
  #define RESC() do{ if(resc){ asm volatile("s_waitcnt lgkmcnt(0)":::"memory"); \
      _Pragma("unroll") for(int d_=0;d_<2;++d_) _Pragma("unroll") for(int r=0;r<16;++r)o[d_][r]*=wsf[crow(r,hi)]; } }while(0)
  f32x16 pA0,pA1,pB0,pB1;
  int sl_prev=0,sl_cur=0,sl_next=SLOTB;
  #define ROT() do{sl_prev=sl_cur;sl_cur=sl_next;sl_next=(sl_next==(NSLOT-1)*SLOTB)?0:sl_next+SLOTB;}while(0)
  DMA_K(2,2*SLOTB);
  WAIT_BAR(3);
  qkt(pA0,pA1,Kbase,qr,negm,r32,hi);asm volatile("s_nop 15\n\ts_nop 7":"+v"(pA0),"+v"(pA1));CMASK(pA0,pA1,0);
  START(pA0,pA1);
  _Pragma("unroll") for(int r=0;r<16;++r)pA1[r]=__builtin_amdgcn_exp2f(pA1[r]);
  WAIT_BAR(0);
  DMA_K(3,0);DMA_V(1,SLOTB);
  ROT();
  kload8(kf,kp0+sl_cur);
  WAIT_BAR(2);
  s16x4 vlo[8],vhi[8]; u32x4 pw0,pw1,pw2,pw3;
  #define PKW(P,B) cvtpk_s(P[B],P[B+1])
  #define PAF(k) __builtin_bit_cast(bf16x8,pw##k)
  #define VFR(i) (bf16x8){vlo[i][0],vlo[i][1],vlo[i][2],vlo[i][3],vhi[i][0],vhi[i][1],vhi[i][2],vhi[i][3]}
  #define PIN(x) asm volatile("":"+v"(x))
  #define MX3(a,b,c) __builtin_fmaxf(__builtin_fmaxf((a),(b)),(c))
  #define GAPA(MF,A0,A1,A2,A3,W0,W1,PW) do{ MF; sacc+=A0; sacc+=A1; sacc+=A2; sacc+=A3; PIN(sacc); W0; W1; PIN(PW); SBAR(); }while(0)
  #define EX(v) __builtin_amdgcn_exp2f(v)
  #define GAPB(MF,X,B) do{ MF; X[B]=EX(X[B]); X[B+1]=EX(X[B+1]); X[B+2]=EX(X[B+2]); X[B+3]=EX(X[B+3]); PIN(X); SBAR(); }while(0)
  #define VRD(i) do{ vlo[i]=vtr(vp_+(((i)>>2)*4096+((i)&3)*1024)); vhi[i]=vtr(vp_+(((i)>>2)*4096+((i)&3)*1024+512)); }while(0)
  #define KRD(G,j) do{ if(G){ kload2(kf,kp0+sl_next,j); SBAR(); } }while(0)
  #define STEP(C0,C1,P0,P1,t,GK,GV,GL) do{ SBAR(); \
    const lds_cptr vp_=vp0+sl_prev; \
    VRD(0); SBAR(); float sacc=(P0[0]+P0[1]); \
    GAPA(C0=__builtin_amdgcn_mfma_f32_32x32x16_bf16(kf[0],qr[0],negm,0,0,0), P0[2],P0[3],P0[4],P0[5],     pw0[0]=PKW(P0,0), pw0[1]=PKW(P0,2), pw0); \
    VRD(4); SBAR(); GAPA(C1=__builtin_amdgcn_mfma_f32_32x32x16_bf16(kf[1],qr[0],negm,0,0,0), P0[6],P0[7],P0[8],P0[9],     pw0[2]=PKW(P0,4), pw0[3]=PKW(P0,6), pw0); \
    VRD(1); SBAR(); GAPA(C0=__builtin_amdgcn_mfma_f32_32x32x16_bf16(kf[2],qr[1],C0,0,0,0),   P0[10],P0[11],P0[12],P0[13], pw1[0]=PKW(P0,8), pw1[1]=PKW(P0,10), pw1); \
    VRD(5); SBAR(); GAPA(C1=__builtin_amdgcn_mfma_f32_32x32x16_bf16(kf[3],qr[1],C1,0,0,0),   P0[14],P0[15],P1[0],P1[1],   pw1[2]=PKW(P0,12),pw1[3]=PKW(P0,14), pw1); \
    VRD(2); SBAR(); GAPA(C0=__builtin_amdgcn_mfma_f32_32x32x16_bf16(kf[4],qr[2],C0,0,0,0),   P1[2],P1[3],P1[4],P1[5],     pw2[0]=PKW(P1,0), pw2[1]=PKW(P1,2), pw2); \
    VRD(6); SBAR(); GAPA(C1=__builtin_amdgcn_mfma_f32_32x32x16_bf16(kf[5],qr[2],C1,0,0,0),   P1[6],P1[7],P1[8],P1[9],     pw2[2]=PKW(P1,4), pw2[3]=PKW(P1,6), pw2); \
    VRD(3); SBAR(); GAPA(C0=__builtin_amdgcn_mfma_f32_32x32x16_bf16(kf[6],qr[3],C0,0,0,0),   P1[10],P1[11],P1[12],P1[13], pw3[0]=PKW(P1,8), pw3[1]=PKW(P1,10), pw3); \
    VRD(7); SBAR(); GAPA(C1=__builtin_amdgcn_mfma_f32_32x32x16_bf16(kf[7],qr[3],C1,0,0,0),   P1[14],P1[15],0.f,0.f,       pw3[2]=PKW(P1,12),pw3[3]=PKW(P1,14), pw3); \
    l_reg+=sacc; \
    if(GK){DMA_K((t)+3,sl_cur);} if(GV){DMA_V((t)+1,sl_next);} \
    CMASK(C0,C1,t); \
    { float a=MX3(C0[0],C0[1],C1[0]),b=MX3(C0[2],C0[3],C1[1]); a=MX3(a,C1[2],C1[3]); \
      _Pragma("unroll") for(int r=4;r<16;r+=4){a=MX3(a,C0[r],C0[r+1]);b=MX3(b,C0[r+2],C0[r+3]);a=MX3(a,C1[r],C1[r+1]);b=MX3(b,C1[r+2],C1[r+3]);} \
      float rm=__builtin_fmaxf(a,b); { auto rr=__builtin_amdgcn_permlane32_swap(__float_as_uint(rm),__float_as_uint(rm),false,false); rm=__builtin_fmaxf(__uint_as_float(rr[0]),__uint_as_float(rr[1])); } \
      resc=false; \
      if(__builtin_expect(__any(rm>(float)THRL),0)){ const float dl=__builtin_fmaxf(rm,0.f); mhat+=dl; \
        _Pragma("unroll") for(int r=0;r<16;++r){C0[r]-=dl;C1[r]-=dl;} \
        _Pragma("unroll") for(int r=0;r<16;++r)negm[r]=-mhat; asm volatile("":"+v"(negm)); \
        const float f=__builtin_amdgcn_exp2f(-dl); l_reg*=f; if(hi==0)wsf[r32]=f; resc=true; } } \
    SBAR(); \
    GAPB(o[0]=__builtin_amdgcn_mfma_f32_32x32x16_bf16(PAF(0),VFR(0),o[0],0,0,0), C0,0); \
    GAPB(o[1]=__builtin_amdgcn_mfma_f32_32x32x16_bf16(PAF(0),VFR(4),o[1],0,0,0), C0,4); \
    KRD(GL,0); GAPB(o[0]=__builtin_amdgcn_mfma_f32_32x32x16_bf16(PAF(1),VFR(1),o[0],0,0,0), C0,8); \
    KRD(GL,1); GAPB(o[1]=__builtin_amdgcn_mfma_f32_32x32x16_bf16(PAF(1),VFR(5),o[1],0,0,0), C0,12); \
    KRD(GL,2); GAPB(o[0]=__builtin_amdgcn_mfma_f32_32x32x16_bf16(PAF(2),VFR(2),o[0],0,0,0), C1,0); \
    KRD(GL,3); GAPB(o[1]=__builtin_amdgcn_mfma_f32_32x32x16_bf16(PAF(2),VFR(6),o[1],0,0,0), C1,4); \
    GAPB(o[0]=__builtin_amdgcn_mfma_f32_32x32x16_bf16(PAF(3),VFR(3),o[0],0,0,0), C1,8); \
    GAPB(o[1]=__builtin_amdgcn_mfma_f32_32x32x16_bf16(PAF(3),VFR(7),o[1],0,0,0), C1,12); \
    }while(0)
  int t=1;
  #undef CMASK
  #define CMASK(P0,P1,t) do{}while(0)
  for(;t+5<NT;t+=2){
    STEP(pB0,pB1,pA0,pA1,t,true,true,true);     WAIT_BAR(2); RESC(); ROT();
    STEP(pA0,pA1,pB0,pB1,t+1,true,true,true);   WAIT_BAR(2); RESC(); ROT();
  }
  #undef CMASK
  #define CMASK(P0,P1,t) do{}while(0)
  #define ENDW(tt) do{ if((tt)+3<NT){WAIT_BAR(2);} else if((tt)+2<NT){WAIT_BAR(1);} else {WAIT_BAR(0);} }while(0)
  for(;t+1<NT;t+=2){
    STEP(pB0,pB1,pA0,pA1,t,(t+3<NT),(t+1<NT),(t+1<NT));       ENDW(t);   RESC(); ROT();
    STEP(pA0,pA1,pB0,pB1,t+1,(t+4<NT),(t+2<NT),(t+2<NT));     ENDW(t+1); RESC(); ROT();
  }
  STEP(pB0,pB1,pA0,pA1,NT-1,false,false,false); RESC();
  { float sacc=pB0[0]+pB0[1]; _Pragma("unroll") for(int r=2;r<16;++r)sacc+=pB0[r]; _Pragma("unroll") for(int r=0;r<16;++r)sacc+=pB1[r]; l_reg+=sacc;
    pw0=(u32x4){PKW(pB0,0),PKW(pB0,2),PKW(pB0,4),PKW(pB0,6)};pw1=(u32x4){PKW(pB0,8),PKW(pB0,10),PKW(pB0,12),PKW(pB0,14)};pw2=(u32x4){PKW(pB1,0),PKW(pB1,2),PKW(pB1,4),PKW(pB1,6)};pw3=(u32x4){PKW(pB1,8),PKW(pB1,10),PKW(pB1,12),PKW(pB1,14)};
    SBAR(); pv(o,vb0+sl_cur,PAF(0),PAF(1),PAF(2),PAF(3)); }
  #undef PKW
  #undef PAF
  #undef VFR
  #undef PIN
  #undef MX3
  #undef GAPA
  #undef GAPB
  #undef EX
  #undef VRD
  #undef KRD
  #undef STEP
  #undef ENDW
  {auto rr=__builtin_amdgcn_permlane32_swap(__float_as_uint(l_reg),__float_as_uint(l_reg),false,false);l_reg=__uint_as_float(rr[0])+__uint_as_float(rr[1]);}
  if(hi==0)wsf[32+r32]=l_reg;asm volatile("s_waitcnt lgkmcnt(0)":::"memory");
  float rli[16];
  #pragma unroll
  for(int r=0;r<16;++r)rli[r]=__builtin_amdgcn_rcpf(wsf[32+crow(r,hi)]);
  bf16*Ow=Ob+(long)(wid*QBLK)*DM;
  { bf16*stg=(bf16*)(shm+LDS_OST)+wid*2048;
    #pragma unroll
    for(int r=0;r<16;++r){const int orow=crow(r,hi);
      #pragma unroll
      for(int d0=0;d0<2;++d0)stg[orow*64+d0*32+r32]=__float2bfloat16(o[d0][r]*rli[r]);}
    asm volatile("s_waitcnt lgkmcnt(0)":::"memory");
    #pragma unroll
    for(int i=0;i<4;++i){const int row=i*8+(lane>>3),ch=lane&7; const u32x4 v=*(const u32x4*)(stg+row*64+ch*8); ATTN_STORE16(Ow+(long)row*DM+ch*8,v);} }
  asm volatile("s_waitcnt lgkmcnt(0)\n\ts_barrier":::"memory");
  #undef DMA_K
  #undef DMA_V
  #undef CMASK
  #undef START
  #undef RESC
  #undef ROT
}
constexpr int ATTN_LDS_BYTES=LDS_BYTES;
#undef SBAR
#undef WAIT_BAR
}
typedef unsigned short bf16_t;
typedef float f32x4 __attribute__((ext_vector_type(4)));
typedef unsigned u32x4 __attribute__((ext_vector_type(4)));
typedef unsigned u32x2 __attribute__((ext_vector_type(2)));
typedef short bf16x8 __attribute__((ext_vector_type(8)));

constexpr int NB = 4, SEQL = 4096, CTXL = 256, ROWB = SEQL + CTXL, NROW = NB * ROWB;
constexpr int DM = 1024, PP = 2816, DFF = 4096, NLAYER = 2, INC = 2712, MODW = 6144;
constexpr int NTHR = 512, NWV = 8;
constexpr float LN_EPS = 1e-6f;
constexpr float DN_ALPHA = 1.41421356237309515f;
constexpr int PC_U = 0, PC_AQ = 256, PC_Z = 640, PC_GV = 1024, PC_AK = 1280, PC_AV = 1408, PC_DQ = 1536, PC_DK = 1920, PC_DV = 2304, PC_AB = 2688;
constexpr size_t MiB = 1u << 20;
constexpr size_t WS_P = 0;
constexpr size_t WS_DNSH = 94 * MiB;
constexpr size_t WS_DNPD = WS_DNSH + (size_t)1632 * 16384;
constexpr size_t WS_DNVEC = WS_DNPD + (size_t)3264 * 24576;
constexpr size_t WS_DNEND = WS_DNVEC + (size_t)3264 * 768;
constexpr size_t WS_H = 0;
constexpr size_t WS_XN = 136 * MiB;
constexpr size_t WS_W = 200 * MiB;
constexpr size_t W_IN_OFF = 0, W_OUT_OFF = (size_t)2816 * 1024 * 2, W_UP_OFF = W_OUT_OFF + (size_t)1024 * 1024 * 2, W_DN_OFF = W_UP_OFF + (size_t)4096 * 1024 * 2, W_LAYER = W_DN_OFF + (size_t)4096 * 1024 * 2;
constexpr size_t WS_XCTX = 247 * MiB;
constexpr size_t WS_AB = 251 * MiB;
constexpr size_t WS_MODV = 253 * MiB;
static_assert(WS_DNEND <= 200 * MiB && WS_W + 2 * W_LAYER <= WS_XCTX && WS_AB + (size_t)NROW * 96 <= WS_MODV, "ws map");

__device__ __forceinline__ float bf2f(unsigned v) { return __uint_as_float(v << 16); }
__device__ __forceinline__ unsigned f2bf(float f) { unsigned u = __float_as_uint(f); return (u + 0x7fffu + ((u >> 16) & 1u)) >> 16; }
__device__ __forceinline__ unsigned pk2(float lo, float hi) { return f2bf(lo) | (f2bf(hi) << 16); }
__device__ __forceinline__ float wave_sum(float v) {
#pragma unroll
    for (int o = 1; o < 64; o <<= 1) v += __shfl_xor(v, o);
    return v;
}
__device__ __forceinline__ float gelu_f(float v) {
    const float t = __builtin_amdgcn_rcpf(fabsf(v) * 0.2316418882f + 1.0f);
    float q = t * 0.5307027145f + (-0.7265760135f); q = q * t + 0.7107068705f; q = q * t + (-0.142248368f); q = q * t + 0.127414796f; q = q * t;
    const float e = __builtin_amdgcn_exp2f((v * v) * (-0.72134752044f));
    const float m = v * (q * e);
    return v < 0.f ? m : v - m;
}
__device__ __forceinline__ float silu_f(float x) { return x / (1.0f + __expf(-x)); }
__device__ __forceinline__ void unpack8(u32x4 w, float (&f)[8]) {
    f[0] = bf2f(w.x & 0xffffu); f[1] = bf2f(w.x >> 16); f[2] = bf2f(w.y & 0xffffu); f[3] = bf2f(w.y >> 16);
    f[4] = bf2f(w.z & 0xffffu); f[5] = bf2f(w.z >> 16); f[6] = bf2f(w.w & 0xffffu); f[7] = bf2f(w.w >> 16);
}
__device__ __forceinline__ u32x4 pack8(const float (&f)[8]) { u32x4 w; w.x = pk2(f[0], f[1]); w.y = pk2(f[2], f[3]); w.z = pk2(f[4], f[5]); w.w = pk2(f[6], f[7]); return w; }

namespace pg8 {
struct EpiP {
    static constexpr bool PERM = true, AFTER_DRAIN = false;
    bf16_t* P; float* AB;
    __device__ __forceinline__ void operator()(const f32x4 (&acc)[2][2][4][2], const Unit& u, int wr, int wc, int fr, int fq) const {
        const int row0 = u.pm * BM + wr * 64 + fr, col0 = u.pn * BM + wc * 32 + 8 * fq;
#pragma unroll
        for (int ai = 0; ai < 2; ++ai)
#pragma unroll
            for (int m = 0; m < 4; ++m) { const int r = row0 + ai * HALF + m * 16;
#pragma unroll
                for (int bj = 0; bj < 2; ++bj) { const int c = col0 + bj * HALF; const f32x4 v0 = acc[ai][bj][m][0], v1 = acc[ai][bj][m][1];
                    u32x4 w; w.x = cvt_pk_bf16(v0[0], v0[1]); w.y = cvt_pk_bf16(v0[2], v0[3]); w.z = cvt_pk_bf16(v1[0], v1[1]); w.w = cvt_pk_bf16(v1[2], v1[3]);
                    *(u32x4*)(P + (size_t)r * PP + c) = w;
                    if (c >= PC_AB && c < INC) { float* ab = AB + (size_t)r * 24 + (c - PC_AB); *(f32x4*)ab = v0; *(f32x4*)(ab + 4) = v1; } } }
    }
};
struct EpiH {
    static constexpr bool PERM = true, AFTER_DRAIN = false;
    bf16_t* H;
    __device__ __forceinline__ void operator()(const f32x4 (&acc)[2][2][4][2], const Unit& u, int wr, int wc, int fr, int fq) const {
        const int row0 = u.pm * BM + wr * 64 + fr, col0 = u.pn * BM + wc * 32 + 8 * fq;
#pragma unroll
        for (int ai = 0; ai < 2; ++ai)
#pragma unroll
            for (int m = 0; m < 4; ++m) { const int r = row0 + ai * HALF + m * 16;
#pragma unroll
                for (int bj = 0; bj < 2; ++bj) { const int c = col0 + bj * HALF; f32x4 v0 = acc[ai][bj][m][0], v1 = acc[ai][bj][m][1];
#pragma unroll
                    for (int e = 0; e < 4; ++e) { const float a = fmaxf(v0[e], 0.f), b = fmaxf(v1[e], 0.f); v0[e] = a * a; v1[e] = b * b; }
                    u32x4 w; w.x = cvt_pk_bf16(v0[0], v0[1]); w.y = cvt_pk_bf16(v0[2], v0[3]); w.z = cvt_pk_bf16(v1[0], v1[1]); w.w = cvt_pk_bf16(v1[2], v1[3]);
                    *(u32x4*)(H + (size_t)r * DFF + c) = w; } }
    }
};
struct EpiRes {
    static constexpr bool PERM = false, AFTER_DRAIN = false;
    const float* srclat; const float* srcctx; float* dstlat; float* dstctx; const float* gate; int compact;
    __device__ __forceinline__ void operator()(const f32x4 (&acc)[2][2][4][2], const Unit& u, int wr, int wc, int fr, int fq) const {
        const int b = compact ? (u.pm >> 4) : u.pm / 17, tt = compact ? (u.pm & 15) : u.pm - b * 17; const bool lat = tt < 16;
        const float* sp = lat ? srclat + (size_t)(b * SEQL + tt * 256) * DM : srcctx + (size_t)(b * CTXL) * DM;
        float* dp = lat ? dstlat + (size_t)(b * SEQL + tt * 256) * DM : dstctx + (size_t)(b * CTXL) * DM;
        const float* gp = gate + (size_t)(lat ? b : 4) * MODW;
#pragma unroll
        for (int bj = 0; bj < 2; ++bj)
#pragma unroll
            for (int n = 0; n < 2; ++n) { const int col = u.pn * BM + bj * HALF + wc * 32 + n * 16 + 4 * fq; const f32x4 gv = *(const f32x4*)(gp + col);
#pragma unroll
                for (int ai = 0; ai < 2; ++ai)
#pragma unroll
                    for (int m = 0; m < 4; ++m) { const size_t off = (size_t)(ai * HALF + wr * 64 + m * 16 + fr) * DM + col;
                        const f32x4 xv = *(const f32x4*)(sp + off); *(f32x4*)(dp + off) = xv * DN_ALPHA + gv * acc[ai][bj][m][n]; } }
    }
};
}

__device__ __forceinline__ int win_src_col(int n0) {
    if (n0 < 256) return n0;
    if (n0 < 640) return 512 + (n0 - 256);
    if (n0 < 1024) return 2304 + (n0 - 640);
    if (n0 < 1280) return 256 + (n0 - 1024);
    if (n0 < 1408) return 896 + (n0 - 1280);
    if (n0 < 1536) return 1024 + (n0 - 1408);
    if (n0 < 2688) return 1152 + (n0 - 1536);
    return n0;
}
__device__ __forceinline__ void transpose_item(const float* W, int K, int Nsrc, int Npad, bf16_t* WT, float* scr, int item, int lane, bool perm) {
    const int nblk = Npad / 32, kb = item / nblk, nb = item - kb * nblk, k0 = 64 * kb, n0 = 32 * nb;
    const int sn = (perm ? win_src_col(n0) : n0) + (lane & 31);
    const bool ok = sn < Nsrc;
#pragma unroll 8
    for (int i = 0; i < 32; ++i) { const int kk = 2 * i + (lane >> 5); scr[kk * 33 + (lane & 31)] = ok ? W[(size_t)(k0 + kk) * Nsrc + sn] : 0.f; }
    __builtin_amdgcn_s_waitcnt(0); asm volatile("" ::: "memory");
    const int c = lane & 7;
#pragma unroll
    for (int j = 0; j < 4; ++j) { const int n = (lane >> 3) + 8 * j; const float* s = scr + (8 * c) * 33 + n;
        u32x4 o; o.x = pk2(s[0 * 33], s[1 * 33]); o.y = pk2(s[2 * 33], s[3 * 33]); o.z = pk2(s[4 * 33], s[5 * 33]); o.w = pk2(s[6 * 33], s[7 * 33]);
        *(u32x4*)(WT + (size_t)(n0 + n) * K + k0 + 8 * c) = o; }
    __builtin_amdgcn_s_waitcnt(0); asm volatile("" ::: "memory");
}

struct Args { const float* in[24]; float* out; unsigned char* ws; };

__device__ __forceinline__ void phase_prologue(const Args& a, unsigned char* lds, int tid, int lane, int wave, int G) {
    float* sc = (float*)lds;
    float* red = (float*)(lds + 20480);
    const float* c = a.in[1]; const float* cctx = a.in[3]; const float* mod_w = a.in[4]; const float* mod_b = a.in[5];
    float* modv = (float*)(a.ws + WS_MODV);
    for (int i = tid; i < 5120; i += NTHR) { const float v = i < 4096 ? c[i] : cctx[i - 4096]; sc[i] = v / (1.0f + expf(-v)); }
    __syncthreads();
    for (int it = blockIdx.x; it < 192; it += G) {
        const int l = it / 96, cb = it - l * 96, col = cb * 64 + lane, k0 = wave * 128;
        const float* W = mod_w + (size_t)l * 1024 * MODW + col;
        float acc0 = 0.f, acc1 = 0.f, acc2 = 0.f, acc3 = 0.f, acc4 = 0.f;
#pragma unroll 16
        for (int k = 0; k < 128; ++k) { const float wv = W[(size_t)(k0 + k) * MODW];
            acc0 += sc[k0 + k] * wv; acc1 += sc[1024 + k0 + k] * wv; acc2 += sc[2048 + k0 + k] * wv; acc3 += sc[3072 + k0 + k] * wv; acc4 += sc[4096 + k0 + k] * wv; }
        red[(wave * 5 + 0) * 64 + lane] = acc0; red[(wave * 5 + 1) * 64 + lane] = acc1; red[(wave * 5 + 2) * 64 + lane] = acc2; red[(wave * 5 + 3) * 64 + lane] = acc3; red[(wave * 5 + 4) * 64 + lane] = acc4;
        __syncthreads();
        if (tid < 320) { const int s = tid >> 6, ln = tid & 63; float sum = 0.f;
#pragma unroll
            for (int w = 0; w < 8; ++w) sum += red[(w * 5 + s) * 64 + ln];
            modv[(size_t)(l * 5 + s) * MODW + cb * 64 + ln] = sum + mod_b[(size_t)l * MODW + cb * 64 + ln]; }
        __syncthreads();
    }
    float* scr = (float*)(lds + 32768 + wave * 8704);
    const int gw = blockIdx.x * NWV + wave, NGW = G * NWV;
    constexpr int I_IN = 16 * 88, I_OUT = 16 * 32, I_UP = 16 * 128, I_DN = 64 * 32, I_L = I_IN + I_OUT + I_UP + I_DN;
    for (int it = gw; it < 2 * I_L; it += NGW) {
        const int l = it / I_L; int r = it - l * I_L; unsigned char* wb = a.ws + WS_W + (size_t)l * W_LAYER;
        if (r < I_IN) { transpose_item(a.in[6] + (size_t)l * 1024 * INC, 1024, INC, 2816, (bf16_t*)(wb + W_IN_OFF), scr, r, lane, true); continue; } r -= I_IN;
        if (r < I_OUT) { transpose_item(a.in[7] + (size_t)l * 1024 * 1024, 1024, 1024, 1024, (bf16_t*)(wb + W_OUT_OFF), scr, r, lane, false); continue; } r -= I_OUT;
        if (r < I_UP) { transpose_item(a.in[22] + (size_t)l * 1024 * DFF, 1024, DFF, DFF, (bf16_t*)(wb + W_UP_OFF), scr, r, lane, false); continue; } r -= I_UP;
        transpose_item(a.in[23] + (size_t)l * DFF * 1024, DFF, 1024, 1024, (bf16_t*)(wb + W_DN_OFF), scr, r, lane, false);
    }
}

template <int MODE>
__device__ __forceinline__ void ln_rows(const float* srclat, const float* srcctx, float* dstlat, float* dstctx, const float* lng, const float* lnb,
                                        const float* modsh  , bf16_t* XN, bool wantxn, bool latonly,
                                        int lane, int wave, int G) {
    const int gw = blockIdx.x * NWV + wave, NGW = G * NWV;
    for (int r = gw; r < NROW; r += NGW) {
        const int b = r / ROWB, t = r - b * ROWB; const bool lat = t < SEQL;
        if (latonly && !lat) continue;
        const size_t ro = lat ? (size_t)(b * SEQL + t) * DM : (size_t)(b * CTXL + t - SEQL) * DM;
        const float* src = (lat ? srclat : srcctx) + ro;
        f32x4 v[4];
#pragma unroll
        for (int j = 0; j < 4; ++j) v[j] = *(const f32x4*)(src + lane * 4 + 256 * j);
        if (MODE == 1) {
            float s = 0.f;
#pragma unroll
            for (int j = 0; j < 4; ++j) s += (v[j][0] + v[j][1]) + (v[j][2] + v[j][3]);
            const float mean = wave_sum(s) * (1.0f / DM); float q = 0.f;
#pragma unroll
            for (int j = 0; j < 4; ++j) { v[j] = v[j] - mean; q += (v[j][0] * v[j][0] + v[j][1] * v[j][1]) + (v[j][2] * v[j][2] + v[j][3] * v[j][3]); }
            const float rstd = 1.0f / sqrtf(wave_sum(q) * (1.0f / DM) + LN_EPS);
            float* dst = (lat ? dstlat : dstctx) + ro;
#pragma unroll
            for (int j = 0; j < 4; ++j) { const f32x4 g = *(const f32x4*)(lng + lane * 4 + 256 * j), bb = *(const f32x4*)(lnb + lane * 4 + 256 * j);
                v[j] = v[j] * rstd * g + bb; *(f32x4*)(dst + lane * 4 + 256 * j) = v[j]; }
        }
        if (wantxn) {
            float s = 0.f;
#pragma unroll
            for (int j = 0; j < 4; ++j) s += (v[j][0] + v[j][1]) + (v[j][2] + v[j][3]);
            const float mean = wave_sum(s) * (1.0f / DM); float q = 0.f;
#pragma unroll
            for (int j = 0; j < 4; ++j) { v[j] = v[j] - mean; q += (v[j][0] * v[j][0] + v[j][1] * v[j][1]) + (v[j][2] * v[j][2] + v[j][3] * v[j][3]); }
            const float rstd = 1.0f / sqrtf(wave_sum(q) * (1.0f / DM) + LN_EPS);
            const float* sh = modsh + (size_t)(lat ? b : 4) * MODW;
            bf16_t* xo = XN + (size_t)r * DM;
#pragma unroll
            for (int j = 0; j < 4; ++j) { const f32x4 shv = *(const f32x4*)(sh + lane * 4 + 256 * j), scv = *(const f32x4*)(sh + 1024 + lane * 4 + 256 * j);
                const f32x4 o = v[j] * rstd * (scv + 1.0f) + shv; u32x2 w; w.x = pk2(o[0], o[1]); w.y = pk2(o[2], o[3]);
                *(u32x2*)(xo + lane * 4 + 256 * j) = w; }
        }
    }
}

#ifndef PROBE_K
#define PROBE_K -1
#endif
#define SUBSTAMP(k, wsp, cond) do { if (PROBE_K == (k) && (cond) && blockIdx.x == 0 && threadIdx.x == 0) { const unsigned long long t1_ = __builtin_amdgcn_s_memrealtime(); const unsigned long long d_ = (t1_ - *(volatile unsigned long long*)((wsp) + 255 * MiB + 8)) * 8; while (__builtin_amdgcn_s_memrealtime() - t1_ < d_) __builtin_amdgcn_s_sleep(8); } } while (0)
__device__ __forceinline__ void gmlp_item(int ci, bf16_t* P, const float* ln_g, const float* ln_b, const float* w_s, const float* b_s, unsigned char* lds, int tid, int lane, int wave) {
    bf16_t* vT = (bf16_t*)lds;
    float* st = (float*)(lds + 17408);
    const int r0 = ci * 128, lr = lane & 15, lq = lane >> 4;
    for (int tt = 0; tt < 16; ++tt) { const int tk = wave * 16 + tt;
        const u32x2 w = *(const u32x2*)(P + (size_t)(r0 + tk) * PP + PC_GV + lane * 4);
        const float x0 = gelu_f(bf2f(w.x & 0xffffu)), x1 = gelu_f(bf2f(w.x >> 16)), x2 = gelu_f(bf2f(w.y & 0xffffu)), x3 = gelu_f(bf2f(w.y >> 16));
        const float mean = wave_sum((x0 + x1) + (x2 + x3)) * (1.0f / 256.0f);
        const float d0 = x0 - mean, d1 = x1 - mean, d2 = x2 - mean, d3 = x3 - mean;
        const float var = wave_sum((d0 * d0 + d1 * d1) + (d2 * d2 + d3 * d3)) * (1.0f / 256.0f);
        if (lane == 0) { st[tk * 2] = mean; st[tk * 2 + 1] = 1.0f / sqrtf(var + LN_EPS); } }
    __syncthreads();
    for (int g = 0; g < 4; ++g) {
        bf16x8 Af[4];
#pragma unroll
        for (int kk = 0; kk < 4; ++kk) { const float* wp = w_s + (size_t)(g * 128 + wave * 16 + lr) * 128 + kk * 32 + lq * 8;
            const f32x4 a0 = *(const f32x4*)wp, a1 = *(const f32x4*)(wp + 4);
            u32x4 w; w.x = pk2(a0[0], a0[1]); w.y = pk2(a0[2], a0[3]); w.z = pk2(a1[0], a1[1]); w.w = pk2(a1[2], a1[3]); Af[kk] = __builtin_bit_cast(bf16x8, w); }
#pragma unroll
        for (int k = 0; k < 8; ++k) { const int idx = tid + NTHR * k, s = idx >> 5, dp = (idx & 31) * 2;
            const unsigned w = *(const unsigned*)(P + (size_t)(r0 + s) * PP + PC_GV + g * 64 + dp);
            const float mean = st[2 * s], rstd = st[2 * s + 1];
            const float y0 = (gelu_f(bf2f(w & 0xffffu)) - mean) * rstd * ln_g[g * 64 + dp] + ln_b[g * 64 + dp];
            const float y1 = (gelu_f(bf2f(w >> 16)) - mean) * rstd * ln_g[g * 64 + dp + 1] + ln_b[g * 64 + dp + 1];
            vT[dp * 136 + s] = (bf16_t)f2bf(y0); vT[(dp + 1) * 136 + s] = (bf16_t)f2bf(y1); }
        __syncthreads();
        f32x4 acc[4];
#pragma unroll
        for (int nt = 0; nt < 4; ++nt) { acc[nt] = (f32x4){0.f, 0.f, 0.f, 0.f};
#pragma unroll
            for (int kk = 0; kk < 4; ++kk) { const bf16x8 bfr = *(const bf16x8*)(vT + (16 * nt + lr) * 136 + kk * 32 + lq * 8);
                acc[nt] = __builtin_amdgcn_mfma_f32_16x16x32_bf16(Af[kk], bfr, acc[nt], 0, 0, 0); } }
#pragma unroll
        for (int jx = 0; jx < 4; ++jx) { const int t = wave * 16 + lq * 4 + jx; const float bs = b_s[g * 128 + t];
#pragma unroll
            for (int nt = 0; nt < 4; ++nt) { bf16_t* up = P + (size_t)(r0 + t) * PP + PC_U + g * 64 + 16 * nt + lr;
                *up = (bf16_t)f2bf(gelu_f(bf2f(*up)) * (acc[nt][jx] + bs)); } }
        __syncthreads();
    }
}

constexpr float ATT_C2 = 0.125f * 1.4426950408889634f;
__device__ __forceinline__ void attn_prep_item(int item, bf16_t* P, const float* q_g, const float* k_g, int lane, int wave) {
    const int hd = lane >> 3, j = lane & 7; const bool isq = hd < 6;
    const int col = isq ? PC_AQ + hd * 64 + j * 8 : PC_AK + (hd - 6) * 64 + j * 8;
    const float* gp = (isq ? q_g : k_g) + j * 8;
    float gam[8];
#pragma unroll
    for (int e = 0; e < 8; ++e) gam[e] = gp[e];
    for (int rr = 0; rr < 8; ++rr) {
        const int r = item * 64 + wave * 8 + rr, b = r / ROWB, t = r - b * ROWB; const bool lat = t < SEQL;
        bf16_t* p = P + (size_t)r * PP + col;
        float x[8]; unpack8(*(const u32x4*)p, x);
        float ss = 0.f;
#pragma unroll
        for (int e = 0; e < 8; ++e) ss += x[e] * x[e];
        ss += __shfl_xor(ss, 1); ss += __shfl_xor(ss, 2); ss += __shfl_xor(ss, 4);
        const float rs = 1.0f / sqrtf(ss * (1.0f / 64.0f) + LN_EPS);
#pragma unroll
        for (int e = 0; e < 8; ++e) x[e] = x[e] * rs * gam[e];
        if (lat) {
            const float pos = (float)((j >> 2) ? (t & 63) : (t >> 6)); const bool x2lane = (j & 2) != 0;
#pragma unroll
            for (int e = 0; e < 8; ++e) { const int f = (j & 1) * 8 + e;
                const float inv = exp2f(-(float)f * (13.287712379549449f / 16.0f)), ang = pos * inv, rev = ang * 0.15915494309189535f;
                const float cs = __builtin_amdgcn_cosf(rev), sn = __builtin_amdgcn_sinf(rev);
                const float other = __shfl_xor(x[e], 2);
                x[e] = x[e] * cs + (x2lane ? other : -other) * sn; }
        }
        if (isq) {
#pragma unroll
            for (int e = 0; e < 8; ++e) x[e] *= ATT_C2;
        }
        *(u32x4*)p = pack8(x);
    }
}

__device__ __forceinline__ void dn_chunk_item(int ck, int h, const bf16_t* P, const float* AB, const float* conv_w, const float* a_log, const float* dt_bias,
                                              unsigned char* ws, unsigned char* lds, int tid_in, int lane_in, bool probe) {
    int tid = tid_in; asm volatile("" : "+v"(tid));
    const int lane = tid & 63;
    float* raw = (float*)lds;
    float* qkv = (float*)(lds + 52224);
    float* KKs = (float*)(lds + 102144);
    float* QKs = (float*)(lds + 118784);
    float* gcs = (float*)(lds + 135424);
    const int r0 = ck * 64, b = r0 / ROWB, t0 = r0 - b * ROWB;
    const int seg_lo = b * ROWB + (t0 < SEQL ? 0 : SEQL), seg_hi = b * ROWB + (t0 < SEQL ? SEQL : ROWB);
    for (int pc = tid; pc < 1632; pc += NTHR) { const int m = pc / 544, rem = pc - m * 544, rr = rem >> 3, ch = rem & 7, row = r0 - 2 + rr;
        float f[8];
#pragma unroll
        for (int e = 0; e < 8; ++e) f[e] = 0.f;
        if (row >= seg_lo && row < seg_hi) unpack8(*(const u32x4*)(P + (size_t)row * PP + PC_DQ + m * 384 + h * 64 + ch * 8), f);
        float* d = raw + (m * 68 + rr) * 64 + ch * 8;
        *(f32x4*)d = (f32x4){f[0], f[1], f[2], f[3]}; *(f32x4*)(d + 4) = (f32x4){f[4], f[5], f[6], f[7]}; }
    __syncthreads();
#pragma unroll 4
    for (int k = 0; k < 24; ++k) { const int idx = tid + NTHR * k, m = idx >> 12, i = (idx >> 6) & 63, d = idx & 63;
        const float* cw = conv_w + m * 384 + h * 64 + d; float s = 0.f;
#pragma unroll
        for (int jj = 0; jj < 5; ++jj) s += cw[jj * 1152] * raw[(m * 68 + i + jj) * 64 + d];
        qkv[(m * 64 + i) * 65 + d] = silu_f(s); }
    __syncthreads();
    { const int row = tid >> 2, part = tid & 3; float* p = qkv + row * 65 + part * 16; float ss = 0.f;
#pragma unroll
        for (int e = 0; e < 16; ++e) ss += p[e] * p[e];
        ss += __shfl_xor(ss, 1); ss += __shfl_xor(ss, 2);
        const float scl = (1.0f / sqrtf(ss + LN_EPS)) * (row < 64 ? 0.125f : 1.0f);
#pragma unroll
        for (int e = 0; e < 16; ++e) p[e] *= scl; }
    __syncthreads();
    unsigned char* shp = ws + WS_DNSH + (size_t)(ck * 6 + h) * 16384;
    { const int rw = tid >> 3, c0 = (tid & 7) * 8; float f[8];
#pragma unroll
        for (int e = 0; e < 8; ++e) f[e] = qkv[rw * 65 + c0 + e];
        *(u32x4*)(shp + (size_t)(rw * 64 + c0) * 2) = pack8(f);
#pragma unroll
        for (int e = 0; e < 8; ++e) f[e] = qkv[(64 + c0 + e) * 65 + rw];
        *(u32x4*)(shp + 8192 + (size_t)(rw * 64 + c0) * 2) = pack8(f); }
    SUBSTAMP(31, ws, probe);
    { const int mat = tid >> 8, ib = (tid >> 4) & 15, jb = tid & 15;
        const float* Ap = qkv + ((mat ? 0 : 64) + ib * 4) * 65; const float* Bp = qkv + (64 + jb * 4) * 65;
        float acc[4][4];
#pragma unroll
        for (int ii = 0; ii < 4; ++ii)
#pragma unroll
            for (int jj = 0; jj < 4; ++jj) acc[ii][jj] = 0.f;
#pragma unroll 8
        for (int d = 0; d < 64; ++d) { float av[4], bv[4];
#pragma unroll
            for (int ii = 0; ii < 4; ++ii) { av[ii] = Ap[ii * 65 + d]; bv[ii] = Bp[ii * 65 + d]; }
#pragma unroll
            for (int ii = 0; ii < 4; ++ii)
#pragma unroll
                for (int jj = 0; jj < 4; ++jj) acc[ii][jj] += av[ii] * bv[jj]; }
        float* Op = (mat ? QKs : KKs) + (ib * 4) * 65 + jb * 4;
#pragma unroll
        for (int ii = 0; ii < 4; ++ii)
#pragma unroll
            for (int jj = 0; jj < 4; ++jj) Op[ii * 65 + jj] = acc[ii][jj]; }
    const int dir = tid >> 8, lt = tid & 255;
    if (lt < 64) { const int i = lt, tok = dir ? 63 - i : i; const float* ab = AB + (size_t)(r0 + tok) * 24;
        const float x = ab[dir * 6 + h] + dt_bias[dir * 6 + h];
        const float sp = fmaxf(x, 0.f) + log1pf(expf(-fabsf(x)));
        float g = -expf(a_log[dir * 6 + h]) * sp;
        const float beta = 1.0f / (1.0f + expf(-ab[12 + dir * 6 + h]));
#pragma unroll
        for (int o = 1; o < 64; o <<= 1) { const float tv = __shfl_up(g, o); if (lane >= o) g += tv; }
        gcs[dir * 64 + i] = g; gcs[128 + dir * 64 + i] = beta; }
    __syncthreads();
    float* Ls = raw + dir * 4096;
    const float* gc = gcs + dir * 64; const float* bt = gcs + 128 + dir * 64;
    for (int e = lt; e < 4096; e += 256) { const int i = e >> 6, jx = e & 63, ti = dir ? 63 - i : i, tj = dir ? 63 - jx : jx;
        Ls[e] = (i > jx) ? bt[i] * KKs[ti * 65 + tj] * expf(gc[i] - gc[jx]) : 0.f; }
    __syncthreads();
    SUBSTAMP(32, ws, probe);
    const int itd = (ck * 6 + h) * 2 + dir;
    unsigned char* pd = ws + WS_DNPD + (size_t)itd * 24576;
    if (lt < 128) {
        const bool isv = lt < 64; const int cc = lt & 63;
        const float* rp = qkv + (isv ? 128 : 64) * 65 + cc;
        float s[64];
#pragma unroll
        for (int i = 0; i < 64; ++i) { const int ti = dir ? 63 - i : i;
            float acc = rp[ti * 65] * bt[i]; if (!isv) acc *= expf(gc[i]);
#pragma unroll
            for (int jx = 0; jx < i; ++jx) acc -= Ls[i * 64 + jx] * s[jx];
            asm volatile("" : "+v"(acc) :: "memory"); s[i] = acc; }
        if (isv) { bf16_t* uT = (bf16_t*)pd + cc * 64;
#pragma unroll
            for (int q8 = 0; q8 < 8; ++q8) { u32x4 w; w.x = pk2(s[q8 * 8], s[q8 * 8 + 1]); w.y = pk2(s[q8 * 8 + 2], s[q8 * 8 + 3]); w.z = pk2(s[q8 * 8 + 4], s[q8 * 8 + 5]); w.w = pk2(s[q8 * 8 + 6], s[q8 * 8 + 7]);
                *(u32x4*)(uT + q8 * 8) = w; } }
        else { bf16_t* wp = (bf16_t*)(pd + 8192) + cc;
#pragma unroll
            for (int i = 0; i < 64; ++i) wp[i * 64] = (bf16_t)f2bf(s[i]); }
    } else {
        const int q = lt - 128, i = q >> 1, hf = q & 1, ti = dir ? 63 - i : i;
        bf16_t* ip = (bf16_t*)(pd + 16384) + i * 64 + hf * 32;
#pragma unroll
        for (int q8 = 0; q8 < 4; ++q8) { float f[8];
#pragma unroll
            for (int e = 0; e < 8; ++e) { const int jx = hf * 32 + q8 * 8 + e, tj = dir ? 63 - jx : jx; f[e] = (i >= jx) ? QKs[ti * 65 + tj] * expf(gc[i] - gc[jx]) : 0.f; }
            *(u32x4*)(ip + q8 * 8) = pack8(f); }
        float* vec = (float*)(ws + WS_DNVEC) + (size_t)itd * 192;
        if (q < 64) { vec[q] = expf(gc[q]); vec[64 + q] = expf(gc[63] - gc[q]); if (q == 0) vec[128] = expf(gc[63]); }
    }
    __syncthreads();    SUBSTAMP(33, ws, probe);
}

__device__ __forceinline__ void dn_scan_unit(int b, int h, int dir, bf16_t* P, const unsigned char* ws, unsigned char* lds, int tid, int lane, int wave) {
    bf16_t* ST = (bf16_t*)lds;
    bf16_t* vnT = ST + 2 * 4608;
    bf16_t* vnT2 = vnT + 4608;
    for (int i = tid; i < 4 * 4608 / 2; i += NTHR) ((unsigned*)lds)[i] = 0u;
    __syncthreads();
    const int mi = wave >> 1, ni0 = (wave & 1) * 2, lr = lane & 15, lq = lane >> 4;
    f32x4 Sacc[2]; Sacc[0] = (f32x4){0.f, 0.f, 0.f, 0.f}; Sacc[1] = Sacc[0];
    int cur = 0;
    const int rowA = 16 * mi + lr, tokA = dir ? 63 - rowA : rowA, c4 = 16 * mi + lq * 4;
    for (int s = 0; s < 68; ++s) {
        const int ckl = dir ? 67 - s : (s < 4 ? 64 + s : s - 4);
        const int ck = b * 68 + ckl, it = ck * 6 + h, itd = it * 2 + dir;
        const unsigned char* shp = ws + WS_DNSH + (size_t)it * 16384;
        const unsigned char* pd = ws + WS_DNPD + (size_t)itd * 24576;
        const float* vec = (const float*)(ws + WS_DNVEC) + (size_t)itd * 192;
        bf16x8 Aw[2], Aq[2], Ai[2], Ak[2]; u32x2 U[2];
#pragma unroll
        for (int kk = 0; kk < 2; ++kk) {
            Aw[kk] = *(const bf16x8*)(pd + 8192 + (size_t)(rowA * 64 + kk * 32 + lq * 8) * 2);
            Aq[kk] = *(const bf16x8*)(shp + (size_t)(tokA * 64 + kk * 32 + lq * 8) * 2);
            Ai[kk] = *(const bf16x8*)(pd + 16384 + (size_t)(rowA * 64 + kk * 32 + lq * 8) * 2);
            Ak[kk] = *(const bf16x8*)(shp + 8192 + (size_t)(rowA * 64 + kk * 32 + lq * 8) * 2); }
#pragma unroll
        for (int n = 0; n < 2; ++n) U[n] = *(const u32x2*)(pd + (size_t)((16 * (ni0 + n) + lr) * 64 + c4) * 2);
        const f32x4 egc4 = *(const f32x4*)(vec + c4), ekd4 = *(const f32x4*)(vec + 64 + c4); const float egl = vec[128];
        bf16x8 BS[2][2];
#pragma unroll
        for (int n = 0; n < 2; ++n)
#pragma unroll
            for (int kk = 0; kk < 2; ++kk) BS[n][kk] = *(const bf16x8*)(ST + cur * 4608 + (16 * (ni0 + n) + lr) * 72 + kk * 32 + lq * 8);
#pragma unroll
        for (int n = 0; n < 2; ++n) { f32x4 acc = (f32x4){0.f, 0.f, 0.f, 0.f};
            acc = __builtin_amdgcn_mfma_f32_16x16x32_bf16(Aw[0], BS[n][0], acc, 0, 0, 0); acc = __builtin_amdgcn_mfma_f32_16x16x32_bf16(Aw[1], BS[n][1], acc, 0, 0, 0);
            const float v0 = bf2f(U[n].x & 0xffffu) - acc[0], v1 = bf2f(U[n].x >> 16) - acc[1], v2 = bf2f(U[n].y & 0xffffu) - acc[2], v3 = bf2f(U[n].y >> 16) - acc[3];
            const int vrow = (16 * (ni0 + n) + lr) * 72;
            u32x2 w; w.x = pk2(v0, v1); w.y = pk2(v2, v3); *(u32x2*)(vnT + vrow + c4) = w;
            const float s0 = v0 * ekd4[0], s1 = v1 * ekd4[1], s2 = v2 * ekd4[2], s3 = v3 * ekd4[3];
            if (dir == 0) { w.x = pk2(s0, s1); w.y = pk2(s2, s3); *(u32x2*)(vnT2 + vrow + c4) = w; }
            else { w.x = pk2(s3, s2); w.y = pk2(s1, s0); *(u32x2*)(vnT2 + vrow + 60 - c4) = w; } }
        __syncthreads();
        const int r0 = ck * 64, ocol = (dir ? PC_DK : PC_DQ) + h * 64;
#pragma unroll
        for (int n = 0; n < 2; ++n) { f32x4 acc = (f32x4){0.f, 0.f, 0.f, 0.f};
            acc = __builtin_amdgcn_mfma_f32_16x16x32_bf16(Aq[0], BS[n][0], acc, 0, 0, 0); acc = __builtin_amdgcn_mfma_f32_16x16x32_bf16(Aq[1], BS[n][1], acc, 0, 0, 0);
            acc = acc * egc4;
            const int vrow = (16 * (ni0 + n) + lr) * 72;
            const bf16x8 bv0 = *(const bf16x8*)(vnT + vrow + lq * 8), bv1 = *(const bf16x8*)(vnT + vrow + 32 + lq * 8);
            acc = __builtin_amdgcn_mfma_f32_16x16x32_bf16(Ai[0], bv0, acc, 0, 0, 0); acc = __builtin_amdgcn_mfma_f32_16x16x32_bf16(Ai[1], bv1, acc, 0, 0, 0);
#pragma unroll
            for (int jx = 0; jx < 4; ++jx) { const int c = c4 + jx, tok = dir ? 63 - c : c;
                P[(size_t)(r0 + tok) * PP + ocol + 16 * (ni0 + n) + lr] = (bf16_t)f2bf(acc[jx]); }
            const bf16x8 b20 = *(const bf16x8*)(vnT2 + vrow + lq * 8), b21 = *(const bf16x8*)(vnT2 + vrow + 32 + lq * 8);
            f32x4 sa = Sacc[n] * egl;
            sa = __builtin_amdgcn_mfma_f32_16x16x32_bf16(Ak[0], b20, sa, 0, 0, 0); sa = __builtin_amdgcn_mfma_f32_16x16x32_bf16(Ak[1], b21, sa, 0, 0, 0);
            Sacc[n] = sa;
            u32x2 w; w.x = pk2(sa[0], sa[1]); w.y = pk2(sa[2], sa[3]); *(u32x2*)(ST + (cur ^ 1) * 4608 + vrow + c4) = w; }
        cur ^= 1;
        __syncthreads();
    }
}

__device__ __forceinline__ void dn_gate_rows(bf16_t* P, const float* norm_g, int lane, int wave, int G) {
    const int gw = blockIdx.x * NWV + wave, NGW = G * NWV; const float ng = norm_g[lane];
    for (int r = gw; r < NROW; r += NGW) { bf16_t* pr = P + (size_t)r * PP;
#pragma unroll
        for (int h = 0; h < 6; ++h) { const float o = bf2f(pr[PC_DQ + h * 64 + lane]) + bf2f(pr[PC_DK + h * 64 + lane]);
            const float ss = wave_sum(o * o); const float z = bf2f(pr[PC_Z + h * 64 + lane]);
            pr[PC_Z + h * 64 + lane] = (bf16_t)f2bf(o * (1.0f / sqrtf(ss * (1.0f / 64.0f) + LN_EPS)) * ng * silu_f(z)); } }
}

#ifndef EN_G1
#define EN_G1 1
#endif
#ifndef EN_G2
#define EN_G2 1
#endif
#ifndef EN_G3
#define EN_G3 1
#endif
#ifndef EN_G4
#define EN_G4 1
#endif
#ifndef EN_PRO
#define EN_PRO 1
#endif
#ifndef EN_GEMM
#define EN_GEMM 1
#endif
#ifndef EN_GMLP
#define EN_GMLP 1
#endif
#ifndef EN_DNC
#define EN_DNC 1
#endif
#ifndef EN_PREP
#define EN_PREP 1
#endif
#ifndef EN_SCAN
#define EN_SCAN 1
#endif
#ifndef EN_ATTN
#define EN_ATTN 1
#endif
#ifndef EN_GATE
#define EN_GATE 1
#endif
#ifndef EN_LN
#define EN_LN 1
#endif
constexpr int LDS_BYTES = 147456;
#ifndef PROBE_K
#define PROBE_K -1
#endif
#ifndef PROBE_MULT
#define PROBE_MULT 1
#endif
#define STAMP(k) do { if (PROBE_K == (k) && blockIdx.x == 0 && threadIdx.x == 0) { const unsigned long long t1_ = __builtin_amdgcn_s_memrealtime(); const unsigned long long d_ = (t1_ - *(volatile unsigned long long*)(a.ws + 255 * MiB)) * PROBE_MULT; while (__builtin_amdgcn_s_memrealtime() - t1_ < d_) __builtin_amdgcn_s_sleep(8); } } while (0)
#define FRESH() do { tid = threadIdx.x; asm volatile("" : "+v"(tid)); lane = tid & 63; wave = __builtin_amdgcn_readfirstlane(tid >> 6); } while (0)
#define FRESHL() do { asm volatile("" : "+s"(l)); wb = ws + WS_W + (size_t)l * W_LAYER; mv = modv + (size_t)l * 5 * MODW; xlat = l == 0 ? a.in[0] : a.out; xctx = l == 0 ? a.in[2] : Xctx; } while (0)
template <int LYR> __device__ __forceinline__ void layer_fwd(const Args& a, unsigned char* lds, cg::grid_group& grid) {
    int tid = threadIdx.x, lane = tid & 63, wave = __builtin_amdgcn_readfirstlane(tid >> 6); const int G = gridDim.x;
    unsigned char* ws = a.ws;
    bf16_t* P = (bf16_t*)(ws + WS_P); bf16_t* XN = (bf16_t*)(ws + WS_XN); bf16_t* H = (bf16_t*)(ws + WS_H);
    float* AB = (float*)(ws + WS_AB); float* Xctx = (float*)(ws + WS_XCTX); float* modv = (float*)(ws + WS_MODV);
    PG8_LAS unsigned char* lds3 = (PG8_LAS unsigned char*)lds;
    int l = LYR;
        const unsigned char* wb; const float* mv; const float* xlat; const float* xctx;
        FRESHL();
        { pg8::Gemm g{XN, (const bf16_t*)(wb + W_IN_OFF), NROW, 2816, 1024, 1024, 0}; pg8::StaticOrder S; S.init(NROW, 2816, G, (int)blockIdx.x);
          pg8::EpiP E{P, AB}; if (EN_GEMM && EN_G1) pg8::gemm_phase<pg8::EpiP, pg8::StaticOrder, true, true>(lds3, g, S, E); }
        grid.sync(); STAMP(2 + 9 * LYR + 0);
        FRESHL();
        if (PROBE_K >= 30 && LYR == 0 && blockIdx.x == 0 && threadIdx.x == 0) *(volatile unsigned long long*)(ws + 255 * MiB + 8) = __builtin_amdgcn_s_memrealtime();
        for (int it = blockIdx.x; it < 136 + 1632 + 272; it += G) { FRESH();
            if (it >= 1632 && it < 1632 + 136) { if (EN_GMLP) gmlp_item(it - 1632, P, a.in[8] + l * 256, a.in[9] + l * 256, a.in[10] + (size_t)l * 4 * 128 * 128, a.in[11] + l * 512, lds, tid, lane, wave); }
            else if (it < 1632) { const int q = it; if (EN_DNC) dn_chunk_item(q / 6, q % 6, P, AB, a.in[14] + (size_t)l * 5 * 1152, a.in[15] + l * 12, a.in[16] + l * 12, ws, lds, tid, lane, LYR == 0 && it == 0); }
            else if (EN_PREP) attn_prep_item(it - 136 - 1632, P, a.in[12] + l * 64, a.in[13] + l * 64, lane, wave);
        }
        grid.sync(); STAMP(2 + 9 * LYR + 1);
        FRESHL();
        FRESH();
        if (blockIdx.x < 48) { const int u = blockIdx.x; if (EN_SCAN) dn_scan_unit(u / 12, (u % 12) >> 1, u & 1, P, ws, lds, tid, lane, wave); }
        else {
            const int nat = (l == 0) ? 408 : 384;
            if (EN_ATTN) for (int u = blockIdx.x - 48; u < nat; u += G - 48) {
                const attn_body::bf16* Pb = (const attn_body::bf16*)P;
                if (u < 384) { const int b = u / 96, rem = u - b * 96, hq = rem >> 4, qb = rem & 15; const size_t rb = (size_t)b * ROWB;
                    attn_body::attn_unit<8>(Pb + (rb + qb * 256) * PP + PC_AQ + hq * 64, Pb + rb * PP + PC_AK + (hq / 3) * 64, Pb + rb * PP + PC_AV + (hq / 3) * 64,
                                            (attn_body::bf16*)P + (rb + qb * 256) * PP + PC_AQ + hq * 64, 68, (char*)lds); }
                else { const int v = u - 384, b = v / 6, hq = v - b * 6; const size_t rb = (size_t)b * ROWB + SEQL;
                    attn_body::attn_unit<8>(Pb + rb * PP + PC_AQ + hq * 64, Pb + rb * PP + PC_AK + (hq / 3) * 64, Pb + rb * PP + PC_AV + (hq / 3) * 64,
                                            (attn_body::bf16*)P + rb * PP + PC_AQ + hq * 64, 4, (char*)lds); }
            }
        }
        grid.sync(); STAMP(2 + 9 * LYR + 2);
        FRESHL();
        FRESH(); if (EN_GATE) dn_gate_rows(P, a.in[17] + l * 64, lane, wave, G);
        grid.sync(); STAMP(2 + 9 * LYR + 3);
        FRESHL();
        { constexpr int MR = LYR == 0 ? NROW : NB * SEQL; pg8::Gemm g{P, (const bf16_t*)(wb + W_OUT_OFF), MR, 1024, 1024, PP, LYR != 0}; pg8::StaticOrder S; S.init(MR, 1024, G, (int)blockIdx.x);
          pg8::EpiRes E{xlat, xctx, a.out, Xctx, mv + 2 * 1024, LYR != 0}; if (EN_GEMM && EN_G2) pg8::gemm_phase<pg8::EpiRes, pg8::StaticOrder, true, true>(lds3, g, S, E); }
        grid.sync(); STAMP(2 + 9 * LYR + 4);
        FRESHL();
        FRESH(); if (EN_LN) ln_rows<1>(a.out, Xctx, a.out, Xctx, a.in[18] + l * 1024, a.in[19] + l * 1024, mv + 3 * 1024, XN, true, LYR != 0, lane, wave, G);
        grid.sync(); STAMP(2 + 9 * LYR + 5);
        FRESHL();
        { constexpr int MR = LYR == 0 ? NROW : NB * SEQL; pg8::Gemm g{XN, (const bf16_t*)(wb + W_UP_OFF), MR, DFF, 1024, 1024, LYR != 0}; pg8::StaticOrder S; S.init(MR, DFF, G, (int)blockIdx.x);
          pg8::EpiH E{H}; if (EN_GEMM && EN_G3) pg8::gemm_phase<pg8::EpiH, pg8::StaticOrder, true, true>(lds3, g, S, E); }
        grid.sync(); STAMP(2 + 9 * LYR + 6);
        FRESHL();
        { constexpr int MR = LYR == 0 ? NROW : NB * SEQL; pg8::Gemm g{H, (const bf16_t*)(wb + W_DN_OFF), MR, 1024, DFF, DFF, 0}; pg8::StaticOrder S; S.init(MR, 1024, G, (int)blockIdx.x);
          pg8::EpiRes E{a.out, Xctx, a.out, Xctx, mv + 5 * 1024, LYR != 0}; if (EN_GEMM && EN_G4) pg8::gemm_phase<pg8::EpiRes, pg8::StaticOrder, true, true>(lds3, g, S, E); }
        grid.sync(); STAMP(2 + 9 * LYR + 7);
        FRESHL();
        FRESH(); if (EN_LN) ln_rows<1>(a.out, Xctx, a.out, Xctx, a.in[20] + l * 1024, a.in[21] + l * 1024, modv + (size_t)(l + 1) * 5 * MODW, XN, l + 1 < NLAYER, l + 1 == NLAYER, lane, wave, G);
        if (l + 1 < NLAYER) grid.sync(); STAMP(2 + 9 * LYR + 8);
}

__global__ void __launch_bounds__(NTHR, 2) mega_fwd(Args a) {
    extern __shared__ __attribute__((aligned(16))) unsigned char lds[];
    cg::grid_group grid = cg::this_grid();
    if (PROBE_K >= 0 && blockIdx.x == 0 && threadIdx.x == 0) *(volatile unsigned long long*)(a.ws + 255 * MiB) = __builtin_amdgcn_s_memrealtime();
    {
        int tid = threadIdx.x, lane = tid & 63, wave = __builtin_amdgcn_readfirstlane(tid >> 6); const int G = gridDim.x;
        unsigned char* ws = a.ws;
        bf16_t* P = (bf16_t*)(ws + WS_P); bf16_t* XN = (bf16_t*)(ws + WS_XN); bf16_t* H = (bf16_t*)(ws + WS_H);
        float* AB = (float*)(ws + WS_AB); float* Xctx = (float*)(ws + WS_XCTX); float* modv = (float*)(ws + WS_MODV);
        PG8_LAS unsigned char* lds3 = (PG8_LAS unsigned char*)lds;
#if EN_PRO
        FRESH(); phase_prologue(a, lds, tid, lane, wave, G);
#endif
        grid.sync(); STAMP(0);
        FRESH(); if (EN_LN) ln_rows<0>(a.in[0], a.in[2], nullptr, nullptr, nullptr, nullptr, modv, XN, true, false, lane, wave, G);
        grid.sync(); STAMP(1);
    }
    layer_fwd<0>(a, lds, grid);
    layer_fwd<1>(a, lds, grid);
    STAMP(20);
}

extern "C" void kernel_launch(void* const* d_in, const int* in_sizes, int n_in, void* d_out, int out_size, void* d_ws, size_t ws_size, hipStream_t stream) {
    static int grid = 0;
    if (grid == 0) {
        int dev = 0, cus = 0, per_cu = 0;
        hipGetDevice(&dev);
        hipDeviceGetAttribute(&cus, hipDeviceAttributeMultiprocessorCount, dev);
        if (hipFuncSetAttribute((const void*)mega_fwd, hipFuncAttributeMaxDynamicSharedMemorySize, LDS_BYTES) != hipSuccess) fprintf(stderr, "kernel_launch: hipFuncSetAttribute failed\n");
        if (hipOccupancyMaxActiveBlocksPerMultiprocessor(&per_cu, (const void*)mega_fwd, NTHR, LDS_BYTES) != hipSuccess || per_cu < 1) { fprintf(stderr, "kernel_launch: occupancy query says %d\n", per_cu); per_cu = 1; }
        (void)hipGetLastError();
        grid = cus * 1;
        if (n_in != 24 || ws_size < 254 * MiB) fprintf(stderr, "kernel_launch: unexpected n_in %d / ws %zu\n", n_in, ws_size);
    }
    Args a{};
    for (int i = 0; i < 24; ++i) a.in[i] = (const float*)d_in[i];
    a.out = (float*)d_out; a.ws = (unsigned char*)d_ws;
    void* params[] = {&a};
    hipError_t e = hipLaunchCooperativeKernel((const void*)mega_fwd, dim3(grid), dim3(NTHR), params, LDS_BYTES, stream);
    if (e != hipSuccess) fprintf(stderr, "kernel_launch: cooperative launch failed: %s (grid %d)\n", hipGetErrorString(e), grid);
}
```

```cpp
#include <hip/hip_runtime.h>
#include <hip/hip_cooperative_groups.h>
#include <cstdio>
#include <cstdint>
namespace cg = cooperative_groups;
namespace pg8 {
#define PG8_LAS __attribute__((address_space(3)))
typedef unsigned short bf16_t;
typedef short bf16x8 __attribute__((ext_vector_type(8)));
typedef float f32x4 __attribute__((ext_vector_type(4)));
typedef unsigned u32x4 __attribute__((ext_vector_type(4)));
constexpr int BM = 256, BK = 64, HALF = 128, HTB = HALF * BK * 2  , STAGE_BYTES = 8 * HTB, NXCD = 8, WGM = 8;

__host__ __device__ __forceinline__ int lds_byte(int r, int c) { const int st = (r >> 4) * 2 + (c >> 5), rr = r & 15, cc = c & 31, ob = rr * 64 + cc * 2; return st * 1024 + (ob ^ (((ob >> 9) & 1) << 5)); }
__host__ __device__ __forceinline__ void stage_rc(int b, int& R, int& C) { const int st = b / 1024, sb = b % 1024, swz = sb ^ (((sb >> 9) & 1) << 5); R = (st >> 1) * 16 + swz / 64; C = (st & 1) * 32 + (swz % 64) / 2; }
__host__ __device__ __forceinline__ int perm32(int rho) { const int n = rho >> 4, i = rho & 15; return 8 * (i >> 2) + 4 * n + (i & 3); }

struct Unit { int pm, pn; };
struct Gemm { const bf16_t* A; const bf16_t* Bt; int M, N, K, lda, amap; };

struct StaticOrder {
    int nM, nN, nwg, G, c;
    __host__ __device__ void init(int M, int N, int G_, int c_) { nM = M / BM; nN = N / BM; nwg = nM * nN; G = G_; c = c_; }
    __host__ __device__ bool next(int i, Unit& u) const {
        const long L = (long)i * G + c; if (L >= nwg) return false;
        int wgid = (int)L; { const int q = nwg / NXCD, r = nwg % NXCD, xcd = wgid % NXCD, off = wgid / NXCD; wgid = (xcd < r ? xcd * (q + 1) : r * (q + 1) + (xcd - r) * q) + off; }
        const int nig = WGM * nN, gid = wgid / nig, fm = gid * WGM, gsz = (nM - fm) < WGM ? (nM - fm) : WGM;
        u.pm = fm + ((wgid % nig) % gsz); u.pn = (wgid % nig) / gsz; return true;
    }
    __device__ __forceinline__ void a_ready(const Unit&) const {}
    __device__ __forceinline__ void done(const Unit&) const {}
};

__device__ __forceinline__ unsigned cvt_pk_bf16(float lo, float hi) { unsigned r; asm volatile("v_cvt_pk_bf16_f32 %0, %1, %2" : "=v"(r) : "v"(lo), "v"(hi)); return r; }
template <class Epi, class Sched, bool ALIGN_EPI = false, bool SP2 = false>
__device__ __forceinline__ void gemm_phase(PG8_LAS unsigned char* lds, const Gemm g, const Sched& S, const Epi& E) {
    int tid_ = threadIdx.x; asm volatile("" : "+v"(tid_)); const int tid = tid_, wid = __builtin_amdgcn_readfirstlane(tid >> 6), lane = tid & 63, wr = wid >> 2, wc = wid & 3, fr = lane & 15, fq = lane >> 4;
    const int K = g.K, nt = K / BK;
    unsigned voffA[2], voffB[2];
#pragma unroll
    for (int i = 0; i < 2; ++i) { int R, C; stage_rc(tid * 16 + i * 8192, R, C); const int Rb = Epi::PERM ? ((R & ~31) + perm32(R & 31)) : R;
        voffA[i] = (unsigned)(R * g.lda + C) * 2u; voffB[i] = (unsigned)(Rb * K + C) * 2u; }
    const size_t kstep = (size_t)(BK * 2);
    const size_t hstepA = (size_t)HALF * g.lda * 2, hstepB = (size_t)HALF * K * 2;
    const size_t tstepA = 2 * hstepA, tstepB = 2 * hstepB;
    const unsigned ldsw = (unsigned)wid * 1024u;
    const int aoff = lds_byte(wr * 64 + fr, fq * 8), boff = lds_byte(wc * 32 + fr, fq * 8);
#define PG8_SA(b, h) (((b) * 2 + (h)) * HTB)
#define PG8_SB(b, h) ((4 + (b) * 2 + (h)) * HTB)
#define PG8_STAGE(bufoff, gbase, voff) do { _Pragma("unroll") for (int _i = 0; _i < 2; ++_i) \
        __builtin_amdgcn_global_load_lds((const unsigned*)((const char*)(gbase) + (voff)[_i]), (PG8_LAS unsigned*)(lds + (bufoff) + ldsw + _i * 8192), 16, 0, 0); } while (0)
#define PG8_LDA(dst, b, h) do { _Pragma("unroll") for (int m = 0; m < 4; ++m) _Pragma("unroll") for (int k = 0; k < 2; ++k) dst[m][k] = *(const PG8_LAS bf16x8*)(lds + PG8_SA(b, h) + aoff + m * 2048 + k * 1024); } while (0)
#define PG8_LDB(dst, b, h) do { _Pragma("unroll") for (int n = 0; n < 2; ++n) _Pragma("unroll") for (int k = 0; k < 2; ++k) dst[n][k] = *(const PG8_LAS bf16x8*)(lds + PG8_SB(b, h) + boff + n * 2048 + k * 1024); } while (0)
#define PG8_MMA(ai, bj, At, Bt) do { __builtin_amdgcn_s_setprio(1); _Pragma("unroll") for (int m = 0; m < 4; ++m) _Pragma("unroll") for (int n = 0; n < 2; ++n) _Pragma("unroll") for (int k = 0; k < 2; ++k) \
        acc[ai][bj][m][n] = __builtin_amdgcn_mfma_f32_16x16x32_bf16(Bt[n][k], At[m][k], acc[ai][bj][m][n], 0, 0, 0); __builtin_amdgcn_s_setprio(0); } while (0)
#define PG8_WAIT_V(n) asm volatile("s_waitcnt vmcnt(" #n ")" ::: "memory")
#define PG8_WAIT_L(n) asm volatile("s_waitcnt lgkmcnt(" #n ")" ::: "memory")
#define PG8_BAR __builtin_amdgcn_s_barrier()
#define PG8_SCHED __builtin_amdgcn_sched_barrier(0)
    Unit cur, nxt; int ui = 0;
    if (!S.next(0, cur)) return;
    f32x4 acc[2][2][4][2];
#pragma unroll
    for (int a = 0; a < 2; ++a)
#pragma unroll
        for (int b = 0; b < 2; ++b)
#pragma unroll
            for (int m = 0; m < 4; ++m)
#pragma unroll
                for (int n = 0; n < 2; ++n) acc[a][b][m][n] = (f32x4){0.f, 0.f, 0.f, 0.f};
    bf16x8 At[4][2], B0[2][2], B1[2][2];
    const char* cA = (const char*)g.A + (size_t)(g.amap ? cur.pm + (cur.pm >> 4) : cur.pm) * tstepA; const char* cB = (const char*)g.Bt + (size_t)cur.pn * tstepB;
    S.a_ready(cur);
    if constexpr (SP2) {
        PG8_STAGE(PG8_SB(0, 0), cB, voffB); PG8_STAGE(PG8_SB(0, 1), cB + hstepB, voffB); PG8_STAGE(PG8_SA(0, 0), cA, voffA); PG8_STAGE(PG8_SA(0, 1), cA + hstepA, voffA);
        if (wr == 1) PG8_BAR;
        PG8_WAIT_V(2); PG8_BAR;
        PG8_STAGE(PG8_SB(1, 0), cB + kstep, voffB); PG8_STAGE(PG8_SA(1, 0), cA + kstep, voffA); PG8_STAGE(PG8_SB(1, 1), cB + hstepB + kstep, voffB);
        PG8_WAIT_V(6); PG8_BAR;
    } else {
        PG8_STAGE(PG8_SB(0, 0), cB, voffB); PG8_STAGE(PG8_SA(0, 0), cA, voffA); PG8_STAGE(PG8_SB(0, 1), cB + hstepB, voffB); PG8_STAGE(PG8_SA(0, 1), cA + hstepA, voffA);
        if (wr == 1) PG8_BAR;
        PG8_WAIT_V(4); PG8_BAR;
        PG8_STAGE(PG8_SB(1, 0), cB + kstep, voffB); PG8_STAGE(PG8_SA(1, 0), cA + kstep, voffA); PG8_STAGE(PG8_SB(1, 1), cB + hstepB + kstep, voffB);
        PG8_WAIT_V(6); PG8_BAR;
    }
    for (;;) {
        const bool has_next = S.next(ui + 1, nxt);
        const char* nA = has_next ? (const char*)g.A + (size_t)(g.amap ? nxt.pm + (nxt.pm >> 4) : nxt.pm) * tstepA : cA; const char* nB = has_next ? (const char*)g.Bt + (size_t)nxt.pn * tstepB : cB;
        for (int t = 0; t < nt; t += 2) {
            const bool last = (t == nt - 2);
            const char* a1 = cA + (size_t)(t + 1) * kstep;
            const char* a2 = last ? nA : cA + (size_t)(t + 2) * kstep; const char* b2 = last ? nB : cB + (size_t)(t + 2) * kstep;
            const char* a3 = a2 + kstep; const char* b3 = b2 + kstep;
            if (last && has_next) S.a_ready(nxt);
            if constexpr (SP2) {
            PG8_LDB(B0, 0, 0); PG8_LDB(B1, 0, 1); PG8_SCHED; PG8_LDA(At, 0, 0); PG8_STAGE(PG8_SA(1, 1), a1 + hstepA, voffA);
            PG8_WAIT_V(8); PG8_WAIT_L(0); PG8_BAR; PG8_MMA(0, 0, At, B0); PG8_MMA(0, 1, At, B1); PG8_BAR; PG8_SCHED;
            PG8_LDA(At, 0, 1); PG8_STAGE(PG8_SB(0, 0), b2, voffB); PG8_STAGE(PG8_SB(0, 1), b2 + hstepB, voffB); PG8_STAGE(PG8_SA(0, 0), a2, voffA);
            PG8_WAIT_V(8); PG8_WAIT_L(0); PG8_BAR; PG8_MMA(1, 0, At, B0); PG8_MMA(1, 1, At, B1); PG8_BAR; PG8_SCHED;
            PG8_LDB(B0, 1, 0); PG8_LDB(B1, 1, 1); PG8_SCHED; PG8_LDA(At, 1, 0); PG8_STAGE(PG8_SA(0, 1), a2 + hstepA, voffA);
            PG8_WAIT_V(8); PG8_WAIT_L(0); PG8_BAR; PG8_MMA(0, 0, At, B0); PG8_MMA(0, 1, At, B1); PG8_BAR; PG8_SCHED;
            PG8_LDA(At, 1, 1); PG8_STAGE(PG8_SB(1, 0), b3, voffB); PG8_STAGE(PG8_SB(1, 1), b3 + hstepB, voffB); PG8_STAGE(PG8_SA(1, 0), a3, voffA);
            PG8_WAIT_V(8); PG8_WAIT_L(0); PG8_BAR; PG8_MMA(1, 0, At, B0); PG8_MMA(1, 1, At, B1); PG8_BAR; PG8_SCHED;
            } else {
            PG8_LDB(B0, 0, 0); PG8_SCHED; PG8_LDA(At, 0, 0); PG8_STAGE(PG8_SA(1, 1), a1 + hstepA, voffA);
            PG8_WAIT_L(8); PG8_BAR; PG8_WAIT_L(0); PG8_MMA(0, 0, At, B0); PG8_BAR; PG8_SCHED;
            PG8_LDB(B1, 0, 1); PG8_STAGE(PG8_SB(0, 0), b2, voffB);
            PG8_BAR; PG8_WAIT_L(0); PG8_MMA(0, 1, At, B1); PG8_BAR;
            PG8_LDA(At, 0, 1); PG8_STAGE(PG8_SA(0, 0), a2, voffA);
            PG8_BAR; PG8_WAIT_L(0); PG8_MMA(1, 0, At, B0); PG8_BAR; PG8_SCHED;
            PG8_STAGE(PG8_SB(0, 1), b2 + hstepB, voffB);
            PG8_WAIT_V(6); PG8_BAR; PG8_MMA(1, 1, At, B1); PG8_BAR;
            PG8_LDB(B0, 1, 0); PG8_SCHED; PG8_LDA(At, 1, 0); PG8_STAGE(PG8_SA(0, 1), a2 + hstepA, voffA);
            PG8_WAIT_L(8); PG8_BAR; PG8_WAIT_L(0); PG8_MMA(0, 0, At, B0); PG8_BAR; PG8_SCHED;
            PG8_LDB(B1, 1, 1); PG8_STAGE(PG8_SB(1, 0), b3, voffB);
            PG8_BAR; PG8_WAIT_L(0); PG8_MMA(0, 1, At, B1); PG8_BAR;
            PG8_LDA(At, 1, 1); PG8_STAGE(PG8_SA(1, 0), a3, voffA);
            PG8_BAR; PG8_WAIT_L(0); PG8_MMA(1, 0, At, B0); PG8_BAR; PG8_SCHED;
            PG8_STAGE(PG8_SB(1, 1), b3 + hstepB, voffB);
            PG8_WAIT_V(6); PG8_BAR; PG8_MMA(1, 1, At, B1); PG8_BAR;
            }
        }
        if constexpr (ALIGN_EPI) { if (wr == 0) PG8_BAR; }
        if constexpr (!Epi::AFTER_DRAIN) { E(acc, cur, wr, wc, fr, fq); S.done(cur); }
        if (!has_next) break;
#pragma unroll
        for (int a = 0; a < 2; ++a)
#pragma unroll
            for (int b = 0; b < 2; ++b)
#pragma unroll
                for (int m = 0; m < 4; ++m)
#pragma unroll
                    for (int n = 0; n < 2; ++n) acc[a][b][m][n] = (f32x4){0.f, 0.f, 0.f, 0.f};
        cur = nxt; cA = nA; cB = nB; ++ui;
        if constexpr (ALIGN_EPI) { if (wr == 1) PG8_BAR; }
    }
    PG8_WAIT_V(0);
    if constexpr (!ALIGN_EPI) { if (wr == 0) PG8_BAR; }
    PG8_BAR;
    if constexpr (Epi::AFTER_DRAIN) { E.fused(acc, cur, wr, wc, fr, fq, lds, wid, lane); S.done(cur); }
#undef PG8_SA
#undef PG8_SB
#undef PG8_STAGE
#undef PG8_LDA
#undef PG8_LDB
#undef PG8_MMA
#undef PG8_WAIT_V
#undef PG8_WAIT_L
#undef PG8_BAR
#undef PG8_SCHED
}
}
#include <hip/hip_bf16.h>
#include <cmath>
namespace attn_body {
using bf16=__hip_bfloat16;
using bf16x8=__attribute__((ext_vector_type(8)))short;
using s16x4=__attribute__((ext_vector_type(4)))short;
using f32x16=__attribute__((ext_vector_type(16)))float;
using u32x4=__attribute__((ext_vector_type(4)))unsigned;
constexpr int D=64,DM=2816;
constexpr int NW=8,QBLK=32,QB=QBLK*NW,KVBLK=64;
constexpr int ATTN_PITCH=DM, ATTN_UNIT_ROWS=QB;
__device__ __forceinline__ int crow(int r,int hi){return (r&3)+8*(r>>2)+4*hi;}
#define SBAR() __builtin_amdgcn_sched_barrier(0)
__device__ __forceinline__ void cmask(f32x16&p0,f32x16&p1,int jb,int qrel,int hi){
  const float NEG=-INFINITY; int kb=64*jb+4*hi;
  #pragma unroll
  for(int r=0;r<16;++r){int kv=kb+(r&3)+8*(r>>2); if(kv>qrel)p0[r]=NEG; if(kv+32>qrel)p1[r]=NEG;}
}

constexpr int NSLOT=3, SLOTB=8192;
constexpr int LDS_K=0, LDS_V=NSLOT*SLOTB, LDS_WS=2*NSLOT*SLOTB, LDS_OST=LDS_WS+NW*64*4, LDS_BYTES=LDS_OST+NW*4096;
constexpr float C2=0.125f*1.4426950408889634f;
__device__ __forceinline__ void glds16(const void*gsrc,unsigned lds_dst){unsigned keep;
  asm volatile("s_mov_b32 %0, m0\n\ts_mov_b32 m0, %2\n\ts_nop 0\n\tglobal_load_lds_dwordx4 %1, off\n\ts_mov_b32 m0, %0":"=&s"(keep):"v"(gsrc),"s"(lds_dst):"memory");}
__device__ __forceinline__ float max3f(float a,float b,float c){float r;asm("v_max3_f32 %0, %1, %2, %3":"=v"(r):"v"(a),"v"(b),"v"(c));return r;}
__device__ __forceinline__ float max2f(float a,float b){float r;asm("v_max_f32_e32 %0, %1, %2":"=v"(r):"v"(a),"v"(b));return r;}
__device__ __forceinline__ float fadd_s(float a,float b){float r;asm("v_add_f32_e32 %0, %1, %2":"=v"(r):"v"(a),"v"(b));return r;}
__device__ __forceinline__ float fsub_s(float a,float b){float r;asm("v_sub_f32_e32 %0, %1, %2":"=v"(r):"v"(a),"v"(b));return r;}
typedef float f32x2_t __attribute__((ext_vector_type(2))); typedef __bf16 bf16x2_t __attribute__((ext_vector_type(2)));
__device__ __forceinline__ unsigned cvtpk_s(float lo,float hi){f32x2_t v={lo,hi};bf16x2_t b=__builtin_convertvector(v,bf16x2_t);return __builtin_bit_cast(unsigned,b);}
#define WAIT_BAR(N) asm volatile("s_waitcnt vmcnt(" #N ") lgkmcnt(0)\n\ts_barrier":::"memory")

__device__ __forceinline__ void qkt(f32x16&p0,f32x16&p1,const char*Kslot,const bf16x8*qr,const f32x16&negm,int r32,int hi){
  const char*kb=Kslot+hi*1024+r32*16;
  #pragma unroll
  for(int d0=0;d0<4;++d0){
    const bf16x8 b0=*reinterpret_cast<const bf16x8*>(kb+d0*2048);
    const bf16x8 b1=*reinterpret_cast<const bf16x8*>(kb+d0*2048+512);
    if(d0==0){p0=__builtin_amdgcn_mfma_f32_32x32x16_bf16(b0,qr[0],negm,0,0,0);p1=__builtin_amdgcn_mfma_f32_32x32x16_bf16(b1,qr[0],negm,0,0,0);}
    else{p0=__builtin_amdgcn_mfma_f32_32x32x16_bf16(b0,qr[d0],p0,0,0,0);p1=__builtin_amdgcn_mfma_f32_32x32x16_bf16(b1,qr[d0],p1,0,0,0);}}
}
typedef __attribute__((address_space(3))) const char* lds_cptr;
typedef short v4i16_t __attribute__((ext_vector_type(4)));
__device__ __forceinline__ void kload8(bf16x8*kf,lds_cptr kp){
  kf[0]=*(const __attribute__((address_space(3))) bf16x8*)(kp);      kf[1]=*(const __attribute__((address_space(3))) bf16x8*)(kp+512);
  kf[2]=*(const __attribute__((address_space(3))) bf16x8*)(kp+2048); kf[3]=*(const __attribute__((address_space(3))) bf16x8*)(kp+2560);
  kf[4]=*(const __attribute__((address_space(3))) bf16x8*)(kp+4096); kf[5]=*(const __attribute__((address_space(3))) bf16x8*)(kp+4608);
  kf[6]=*(const __attribute__((address_space(3))) bf16x8*)(kp+6144); kf[7]=*(const __attribute__((address_space(3))) bf16x8*)(kp+6656);
}
__device__ __forceinline__ void kload2(bf16x8*kf,lds_cptr kp,int j){ kf[2*j]=*(const __attribute__((address_space(3))) bf16x8*)(kp+j*2048); kf[2*j+1]=*(const __attribute__((address_space(3))) bf16x8*)(kp+j*2048+512); }
__device__ __forceinline__ s16x4 vtr(lds_cptr p){ return __builtin_bit_cast(s16x4,__builtin_amdgcn_ds_read_tr16_b64_v4i16((__attribute__((address_space(3))) v4i16_t*)p)); }
__device__ __forceinline__ float rowmax(const f32x16&p0,const f32x16&p1){
  float a=max3f(p0[0],p0[1],p1[0]),b=max3f(p0[2],p0[3],p1[1]);a=max3f(a,p1[2],p1[3]);
  #pragma unroll
  for(int r=4;r<16;r+=4){a=max3f(a,p0[r],p0[r+1]);b=max3f(b,p0[r+2],p0[r+3]);a=max3f(a,p1[r],p1[r+1]);b=max3f(b,p1[r+2],p1[r+3]);}
  const float m=max2f(a,b);
  auto rr=__builtin_amdgcn_permlane32_swap(__float_as_uint(m),__float_as_uint(m),false,false);
  return max2f(__uint_as_float(rr[0]),__uint_as_float(rr[1]));
}
__device__ __forceinline__ void pv(f32x16*o,int vb,bf16x8 pa0,bf16x8 pa1,bf16x8 pa2,bf16x8 pa3){
  #pragma unroll
  for(int d0=0;d0<2;++d0){s16x4 lo[4],hi[4];
    #pragma unroll
    for(int ks=0;ks<4;++ks){
      asm volatile("ds_read_b64_tr_b16 %0,%1 offset:%c2":"=&v"(lo[ks]):"v"(vb),"i"(d0*4096+ks*1024):"memory");
      asm volatile("ds_read_b64_tr_b16 %0,%1 offset:%c2":"=&v"(hi[ks]):"v"(vb),"i"(d0*4096+ks*1024+512):"memory");}
    asm volatile("s_waitcnt lgkmcnt(0)":::"memory");SBAR();
    #define PK(k) (bf16x8){lo[k][0],lo[k][1],lo[k][2],lo[k][3],hi[k][0],hi[k][1],hi[k][2],hi[k][3]}
    o[d0]=__builtin_amdgcn_mfma_f32_32x32x16_bf16(pa0,PK(0),o[d0],0,0,0);
    o[d0]=__builtin_amdgcn_mfma_f32_32x32x16_bf16(pa1,PK(1),o[d0],0,0,0);
    o[d0]=__builtin_amdgcn_mfma_f32_32x32x16_bf16(pa2,PK(2),o[d0],0,0,0);
    o[d0]=__builtin_amdgcn_mfma_f32_32x32x16_bf16(pa3,PK(3),o[d0],0,0,0);
    #undef PK
  }
}

#ifndef ATTN_STORE16
#define ATTN_STORE16(p,v) (*(u32x4*)(p)=(v))
#endif
template<int THRL> __device__ __forceinline__ void attn_unit(const bf16*Qb,const bf16*Kh,const bf16*Vh,bf16*Ob,const int NT,char*shm){
  int tid_=threadIdx.x; asm volatile("":"+v"(tid_)); const int tid=tid_,lane=tid&63,r32=lane&31,hi=lane>>5; const int wid=__builtin_amdgcn_readfirstlane(tid>>6);
  const bf16*Qw=Qb+(long)(wid*QBLK)*DM;
  const unsigned lds0=(unsigned)(uintptr_t)shm;
  float*wsf=(float*)(shm+LDS_WS)+wid*64;
  const bf16*ksrc=Kh+(long)lane*DM+wid*8;
  const bf16*vsrc=Vh+(long)(16*(wid&3)+(lane>>2))*DM+(wid>>2)*32+(lane&3)*8;
  const unsigned kdst=lds0+LDS_K+wid*1024, vdst=lds0+LDS_V+wid*1024;
  #define DMA_K(t,slot) glds16(ksrc+(long)(t)*KVBLK*DM,(unsigned)__builtin_amdgcn_readfirstlane(kdst+(slot)))
  #define DMA_V(t,slot) glds16(vsrc+(long)(t)*KVBLK*DM,(unsigned)__builtin_amdgcn_readfirstlane(vdst+(slot)))
  const int vb0=(int)(lds0+LDS_V)+((lane>>4)&1)*32+(lane&3)*8+(4*hi+((lane&15)>>2))*64;
  const char*Kbase=shm+LDS_K; bf16x8 kf[8];
  const lds_cptr shm3=(lds_cptr)shm; const lds_cptr kp0=shm3+LDS_K+hi*1024+r32*16; const lds_cptr vp0=shm3+LDS_V+((lane>>4)&1)*32+(lane&3)*8+(4*hi+((lane&15)>>2))*64;
  DMA_K(0,0);DMA_V(0,0);DMA_K(1,SLOTB);
  bf16x8 qr[4];
  #pragma unroll
  for(int d0=0;d0<4;++d0)qr[d0]=*reinterpret_cast<const bf16x8*>(&Qw[(long)r32*DM+d0*16+hi*8]);
  float mhat=0.f,l_reg=0.f;f32x16 o[2];o[0]=f32x16{};o[1]=f32x16{};f32x16 negm=f32x16{};asm volatile("":"+v"(negm));
  #define CMASK(P0,P1,t) do{}while(0)
  bool resc=false;
  #define START(P0,P1) do{ const float rm=rowmax(P0,P1); resc=false; \
    { const float dl=rm; mhat=fadd_s(mhat,dl); \
      _Pragma("unroll") for(int r=0;r<16;++r){P0[r]=fsub_s(P0[r],dl);P1[r]=fsub_s(P1[r],dl);} \
      _Pragma("unroll") for(int r=0;r<16;++r)negm[r]=-mhat; asm volatile("":"+v"(negm)); } \
    _Pragma("unroll") for(int r=0;r<16;++r)P0[r]=__builtin_amdgcn_exp2f(P0[r]); }while(0)
  #define RESC() do{ if(resc){ asm volatile("s_waitcnt lgkmcnt(0)":::"memory"); \
      _Pragma("unroll") for(int d_=0;d_<2;++d_) _Pragma("unroll") for(int r=0;r<16;++r)o[d_][r]*=wsf[crow(r,hi)]; } }while(0)
  f32x16 pA0,pA1,pB0,pB1;
  int sl_prev=0,sl_cur=0,sl_next=SLOTB;
  #define ROT() do{sl_prev=sl_cur;sl_cur=sl_next;sl_next=(sl_next==(NSLOT-1)*SLOTB)?0:sl_next+SLOTB;}while(0)
  DMA_K(2,2*SLOTB);
  WAIT_BAR(3);
  qkt(pA0,pA1,Kbase,qr,negm,r32,hi);asm volatile("s_nop 15\n\ts_nop 7":"+v"(pA0),"+v"(pA1));CMASK(pA0,pA1,0);
  START(pA0,pA1);
  _Pragma("unroll") for(int r=0;r<16;++r)pA1[r]=__builtin_amdgcn_exp2f(pA1[r]);
  WAIT_BAR(0);
  DMA_K(3,0);DMA_V(1,SLOTB);
  ROT();
  kload8(kf,kp0+sl_cur);
  WAIT_BAR(2);
  s16x4 vlo[8],vhi[8]; u32x4 pw0,pw1,pw2,pw3;
  #define PKW(P,B) cvtpk_s(P[B],P[B+1])
  #define PAF(k) __builtin_bit_cast(bf16x8,pw##k)
  #define VFR(i) (bf16x8){vlo[i][0],vlo[i][1],vlo[i][2],vlo[i][3],vhi[i][0],vhi[i][1],vhi[i][2],vhi[i][3]}
  #define PIN(x) asm volatile("":"+v"(x))
  #define MX3(a,b,c) __builtin_fmaxf(__builtin_fmaxf((a),(b)),(c))
  #define GAPA(MF,A0,A1,A2,A3,W0,W1,PW) do{ MF; sacc+=A0; sacc+=A1; sacc+=A2; sacc+=A3; PIN(sacc); W0; W1; PIN(PW); SBAR(); }while(0)
  #define EX(v) __builtin_amdgcn_exp2f(v)
  #define GAPB(MF,X,B) do{ MF; X[B]=EX(X[B]); X[B+1]=EX(X[B+1]); X[B+2]=EX(X[B+2]); X[B+3]=EX(X[B+3]); PIN(X); SBAR(); }while(0)
  #define VRD(i) do{ vlo[i]=vtr(vp_+(((i)>>2)*4096+((i)&3)*1024)); vhi[i]=vtr(vp_+(((i)>>2)*4096+((i)&3)*1024+512)); }while(0)
  #define KRD(G,j) do{ if(G){ kload2(kf,kp0+sl_next,j); SBAR(); } }while(0)
  #define STEP(C0,C1,P0,P1,t,GK,GV,GL) do{ SBAR(); \
    const lds_cptr vp_=vp0+sl_prev; \
    VRD(0); SBAR(); float sacc=(P0[0]+P0[1]); \
    GAPA(C0=__builtin_amdgcn_mfma_f32_32x32x16_bf16(kf[0],qr[0],negm,0,0,0), P0[2],P0[3],P0[4],P0[5],     pw0[0]=PKW(P0,0), pw0[1]=PKW(P0,2), pw0); \
    VRD(4); SBAR(); GAPA(C1=__builtin_amdgcn_mfma_f32_32x32x16_bf16(kf[1],qr[0],negm,0,0,0), P0[6],P0[7],P0[8],P0[9],     pw0[2]=PKW(P0,4), pw0[3]=PKW(P0,6), pw0); \
    VRD(1); SBAR(); GAPA(C0=__builtin_amdgcn_mfma_f32_32x32x16_bf16(kf[2],qr[1],C0,0,0,0),   P0[10],P0[11],P0[12],P0[13], pw1[0]=PKW(P0,8), pw1[1]=PKW(P0,10), pw1); \
    VRD(5); SBAR(); GAPA(C1=__builtin_amdgcn_mfma_f32_32x32x16_bf16(kf[3],qr[1],C1,0,0,0),   P0[14],P0[15],P1[0],P1[1],   pw1[2]=PKW(P0,12),pw1[3]=PKW(P0,14), pw1); \
    VRD(2); SBAR(); GAPA(C0=__builtin_amdgcn_mfma_f32_32x32x16_bf16(kf[4],qr[2],C0,0,0,0),   P1[2],P1[3],P1[4],P1[5],     pw2[0]=PKW(P1,0), pw2[1]=PKW(P1,2), pw2); \
    VRD(6); SBAR(); GAPA(C1=__builtin_amdgcn_mfma_f32_32x32x16_bf16(kf[5],qr[2],C1,0,0,0),   P1[6],P1[7],P1[8],P1[9],     pw2[2]=PKW(P1,4), pw2[3]=PKW(P1,6), pw2); \
    VRD(3); SBAR(); GAPA(C0=__builtin_amdgcn_mfma_f32_32x32x16_bf16(kf[6],qr[3],C0,0,0,0),   P1[10],P1[11],P1[12],P1[13], pw3[0]=PKW(P1,8), pw3[1]=PKW(P1,10), pw3); \
    VRD(7); SBAR(); GAPA(C1=__builtin_amdgcn_mfma_f32_32x32x16_bf16(kf[7],qr[3],C1,0,0,0),   P1[14],P1[15],0.f,0.f,       pw3[2]=PKW(P1,12),pw3[3]=PKW(P1,14), pw3); \
    l_reg+=sacc; \
    if(GK){DMA_K((t)+3,sl_cur);} if(GV){DMA_V((t)+1,sl_next);} \
    CMASK(C0,C1,t); \
    { float a=MX3(C0[0],C0[1],C1[0]),b=MX3(C0[2],C0[3],C1[1]); a=MX3(a,C1[2],C1[3]); \
      _Pragma("unroll") for(int r=4;r<16;r+=4){a=MX3(a,C0[r],C0[r+1]);b=MX3(b,C0[r+2],C0[r+3]);a=MX3(a,C1[r],C1[r+1]);b=MX3(b,C1[r+2],C1[r+3]);} \
      float rm=__builtin_fmaxf(a,b); { auto rr=__builtin_amdgcn_permlane32_swap(__float_as_uint(rm),__float_as_uint(rm),false,false); rm=__builtin_fmaxf(__uint_as_float(rr[0]),__uint_as_float(rr[1])); } \
      resc=false; \
      if(__builtin_expect(__any(rm>(float)THRL),0)){ const float dl=__builtin_fmaxf(rm,0.f); mhat+=dl; \
        _Pragma("unroll") for(int r=0;r<16;++r){C0[r]-=dl;C1[r]-=dl;} \
        _Pragma("unroll") for(int r=0;r<16;++r)negm[r]=-mhat; asm volatile("":"+v"(negm)); \
        const float f=__builtin_amdgcn_exp2f(-dl); l_reg*=f; if(hi==0)wsf[r32]=f; resc=true; } } \
    SBAR(); \
    GAPB(o[0]=__builtin_amdgcn_mfma_f32_32x32x16_bf16(PAF(0),VFR(0),o[0],0,0,0), C0,0); \
    GAPB(o[1]=__builtin_amdgcn_mfma_f32_32x32x16_bf16(PAF(0),VFR(4),o[1],0,0,0), C0,4); \
    KRD(GL,0); GAPB(o[0]=__builtin_amdgcn_mfma_f32_32x32x16_bf16(PAF(1),VFR(1),o[0],0,0,0), C0,8); \
    KRD(GL,1); GAPB(o[1]=__builtin_amdgcn_mfma_f32_32x32x16_bf16(PAF(1),VFR(5),o[1],0,0,0), C0,12); \
    KRD(GL,2); GAPB(o[0]=__builtin_amdgcn_mfma_f32_32x32x16_bf16(PAF(2),VFR(2),o[0],0,0,0), C1,0); \
    KRD(GL,3); GAPB(o[1]=__builtin_amdgcn_mfma_f32_32x32x16_bf16(PAF(2),VFR(6),o[1],0,0,0), C1,4); \
    GAPB(o[0]=__builtin_amdgcn_mfma_f32_32x32x16_bf16(PAF(3),VFR(3),o[0],0,0,0), C1,8); \
    GAPB(o[1]=__builtin_amdgcn_mfma_f32_32x32x16_bf16(PAF(3),VFR(7),o[1],0,0,0), C1,12); \
    }while(0)
  int t=1;
  #undef CMASK
  #define CMASK(P0,P1,t) do{}while(0)
  for(;t+5<NT;t+=2){
    STEP(pB0,pB1,pA0,pA1,t,true,true,true);     WAIT_BAR(2); RESC(); ROT();
    STEP(pA0,pA1,pB0,pB1,t+1,true,true,true);   WAIT_BAR(2); RESC(); ROT();
  }
  #undef CMASK
  #define CMASK(P0,P1,t) do{}while(0)
  #define ENDW(tt) do{ if((tt)+3<NT){WAIT_BAR(2);} else if((tt)+2<NT){WAIT_BAR(1);} else {WAIT_BAR(0);} }while(0)
  for(;t+1<NT;t+=2){
    STEP(pB0,pB1,pA0,pA1,t,(t+3<NT),(t+1<NT),(t+1<NT));       ENDW(t);   RESC(); ROT();
    STEP(pA0,pA1,pB0,pB1,t+1,(t+4<NT),(t+2<NT),(t+2<NT));     ENDW(t+1); RESC(); ROT();
  }
  STEP(pB0,pB1,pA0,pA1,NT-1,false,false,false); RESC();
  { float sacc=pB0[0]+pB0[1]; _Pragma("unroll") for(int r=2;r<16;++r)sacc+=pB0[r]; _Pragma("unroll") for(int r=0;r<16;++r)sacc+=pB1[r]; l_reg+=sacc;
    pw0=(u32x4){PKW(pB0,0),PKW(pB0,2),PKW(pB0,4),PKW(pB0,6)};pw1=(u32x4){PKW(pB0,8),PKW(pB0,10),PKW(pB0,12),PKW(pB0,14)};pw2=(u32x4){PKW(pB1,0),PKW(pB1,2),PKW(pB1,4),PKW(pB1,6)};pw3=(u32x4){PKW(pB1,8),PKW(pB1,10),PKW(pB1,12),PKW(pB1,14)};
    SBAR(); pv(o,vb0+sl_cur,PAF(0),PAF(1),PAF(2),PAF(3)); }
  #undef PKW
  #undef PAF
  #undef VFR
  #undef PIN
  #undef MX3
  #undef GAPA
  #undef GAPB
  #undef EX
  #undef VRD
  #undef KRD
  #undef STEP
  #undef ENDW
  {auto rr=__builtin_amdgcn_permlane32_swap(__float_as_uint(l_reg),__float_as_uint(l_reg),false,false);l_reg=__uint_as_float(rr[0])+__uint_as_float(rr[1]);}
  if(hi==0)wsf[32+r32]=l_reg;asm volatile("s_waitcnt lgkmcnt(0)":::"memory");
  float rli[16];
  #pragma unroll
  for(int r=0;r<16;++r)rli[r]=__builtin_amdgcn_rcpf(wsf[32+crow(r,hi)]);
  bf16*Ow=Ob+(long)(wid*QBLK)*DM;
  { bf16*stg=(bf16*)(shm+LDS_OST)+wid*2048;
    #pragma unroll
    for(int r=0;r<16;++r){const int orow=crow(r,hi);
      #pragma unroll
      for(int d0=0;d0<2;++d0)stg[orow*64+d0*32+r32]=__float2bfloat16(o[d0][r]*rli[r]);}
    asm volatile("s_waitcnt lgkmcnt(0)":::"memory");
    #pragma unroll
    for(int i=0;i<4;++i){const int row=i*8+(lane>>3),ch=lane&7; const u32x4 v=*(const u32x4*)(stg+row*64+ch*8); ATTN_STORE16(Ow+(long)row*DM+ch*8,v);} }
  asm volatile("s_waitcnt lgkmcnt(0)\n\ts_barrier":::"memory");
  #undef DMA_K
  #undef DMA_V
  #undef CMASK
  #undef START
  #undef RESC
  #undef ROT
}
constexpr int ATTN_LDS_BYTES=LDS_BYTES;
#undef SBAR
#undef WAIT_BAR
}
typedef unsigned short bf16_t;
typedef float f32x4 __attribute__((ext_vector_type(4)));
typedef unsigned u32x4 __attribute__((ext_vector_type(4)));
typedef unsigned u32x2 __attribute__((ext_vector_type(2)));
typedef short bf16x8 __attribute__((ext_vector_type(8)));

constexpr int NB = 4, SEQL = 4096, CTXL = 256, ROWB = SEQL + CTXL, NROW = NB * ROWB;
constexpr int DM = 1024, PP = 2816, DFF = 4096, NLAYER = 2, INC = 2712, MODW = 6144;
constexpr int NTHR = 512, NWV = 8;
constexpr float LN_EPS = 1e-6f;
constexpr float DN_ALPHA = 1.41421356237309515f;
constexpr int PC_U = 0, PC_AQ = 256, PC_Z = 640, PC_GV = 1024, PC_AK = 1280, PC_AV = 1408, PC_DQ = 1536, PC_DK = 1920, PC_DV = 2304, PC_AB = 2688;
constexpr size_t MiB = 1u << 20;
constexpr size_t WS_P = 0;
constexpr size_t WS_DNSH = 94 * MiB;
constexpr size_t WS_DNPD = WS_DNSH + (size_t)1632 * 16384;
constexpr size_t WS_DNVEC = WS_DNPD + (size_t)3264 * 24576;
constexpr size_t WS_DNEND = WS_DNVEC + (size_t)3264 * 768;
constexpr size_t WS_H = 0;
constexpr size_t WS_XN = 136 * MiB;
constexpr size_t WS_W = 200 * MiB;
constexpr size_t W_IN_OFF = 0, W_OUT_OFF = (size_t)2816 * 1024 * 2, W_UP_OFF = W_OUT_OFF + (size_t)1024 * 1024 * 2, W_DN_OFF = W_UP_OFF + (size_t)4096 * 1024 * 2, W_LAYER = W_DN_OFF + (size_t)4096 * 1024 * 2;
constexpr size_t WS_XCTX = 247 * MiB;
constexpr size_t WS_AB = 251 * MiB;
constexpr size_t WS_MODV = 253 * MiB;
static_assert(WS_DNEND <= 200 * MiB && WS_W + 2 * W_LAYER <= WS_XCTX && WS_AB + (size_t)NROW * 96 <= WS_MODV, "ws map");

__device__ __forceinline__ float bf2f(unsigned v) { return __uint_as_float(v << 16); }
typedef float f32x2_t __attribute__((ext_vector_type(2))); typedef __bf16 bf16x2_t __attribute__((ext_vector_type(2)));
__device__ __forceinline__ unsigned pk2(float lo, float hi) { f32x2_t v = {lo, hi}; return __builtin_bit_cast(unsigned, __builtin_convertvector(v, bf16x2_t)); }
__device__ __forceinline__ unsigned f2bf(float f) { return pk2(f, 0.f) & 0xffffu; }
__device__ __forceinline__ float wave_sum(float v) {
#pragma unroll
    for (int o = 1; o < 64; o <<= 1) v += __shfl_xor(v, o);
    return v;
}
__device__ __forceinline__ float gelu_f(float v) {
    const float t = __builtin_amdgcn_rcpf(fabsf(v) * 0.2316418882f + 1.0f);
    float q = t * 0.5307027145f + (-0.7265760135f); q = q * t + 0.7107068705f; q = q * t + (-0.142248368f); q = q * t + 0.127414796f; q = q * t;
    const float e = __builtin_amdgcn_exp2f((v * v) * (-0.72134752044f));
    const float m = v * (q * e);
    return v < 0.f ? m : v - m;
}
__device__ __forceinline__ float silu_f(float x) { return x / (1.0f + __expf(-x)); }
__device__ __forceinline__ void unpack8(u32x4 w, float (&f)[8]) {
    f[0] = bf2f(w.x & 0xffffu); f[1] = bf2f(w.x >> 16); f[2] = bf2f(w.y & 0xffffu); f[3] = bf2f(w.y >> 16);
    f[4] = bf2f(w.z & 0xffffu); f[5] = bf2f(w.z >> 16); f[6] = bf2f(w.w & 0xffffu); f[7] = bf2f(w.w >> 16);
}
__device__ __forceinline__ u32x4 pack8(const float (&f)[8]) { u32x4 w; w.x = pk2(f[0], f[1]); w.y = pk2(f[2], f[3]); w.z = pk2(f[4], f[5]); w.w = pk2(f[6], f[7]); return w; }

namespace pg8 {
struct EpiP {
    static constexpr bool PERM = true, AFTER_DRAIN = false;
    bf16_t* P; float* AB;
    __device__ __forceinline__ void operator()(const f32x4 (&acc)[2][2][4][2], const Unit& u, int wr, int wc, int fr, int fq) const {
        const int row0 = u.pm * BM + wr * 64 + fr, col0 = u.pn * BM + wc * 32 + 8 * fq;
#pragma unroll
        for (int ai = 0; ai < 2; ++ai)
#pragma unroll
            for (int m = 0; m < 4; ++m) { const int r = row0 + ai * HALF + m * 16;
#pragma unroll
                for (int bj = 0; bj < 2; ++bj) { const int c = col0 + bj * HALF; const f32x4 v0 = acc[ai][bj][m][0], v1 = acc[ai][bj][m][1];
                    u32x4 w; w.x = cvt_pk_bf16(v0[0], v0[1]); w.y = cvt_pk_bf16(v0[2], v0[3]); w.z = cvt_pk_bf16(v1[0], v1[1]); w.w = cvt_pk_bf16(v1[2], v1[3]);
                    *(u32x4*)(P + (size_t)r * PP + c) = w;
                    if (c >= PC_AB && c < INC) { float* ab = AB + (size_t)r * 24 + (c - PC_AB); *(f32x4*)ab = v0; *(f32x4*)(ab + 4) = v1; } } }
    }
};
struct EpiH {
    static constexpr bool PERM = true, AFTER_DRAIN = false;
    bf16_t* H;
    __device__ __forceinline__ void operator()(const f32x4 (&acc)[2][2][4][2], const Unit& u, int wr, int wc, int fr, int fq) const {
        const int row0 = u.pm * BM + wr * 64 + fr, col0 = u.pn * BM + wc * 32 + 8 * fq;
#pragma unroll
        for (int ai = 0; ai < 2; ++ai)
#pragma unroll
            for (int m = 0; m < 4; ++m) { const int r = row0 + ai * HALF + m * 16;
#pragma unroll
                for (int bj = 0; bj < 2; ++bj) { const int c = col0 + bj * HALF; f32x4 v0 = acc[ai][bj][m][0], v1 = acc[ai][bj][m][1];
#pragma unroll
                    for (int e = 0; e < 4; ++e) { const float a = fmaxf(v0[e], 0.f), b = fmaxf(v1[e], 0.f); v0[e] = a * a; v1[e] = b * b; }
                    u32x4 w; w.x = cvt_pk_bf16(v0[0], v0[1]); w.y = cvt_pk_bf16(v0[2], v0[3]); w.z = cvt_pk_bf16(v1[0], v1[1]); w.w = cvt_pk_bf16(v1[2], v1[3]);
                    *(u32x4*)(H + (size_t)r * DFF + c) = w; } }
    }
};
struct EpiRes {
    static constexpr bool PERM = false, AFTER_DRAIN = false;
    const float* srclat; const float* srcctx; float* dstlat; float* dstctx; const float* gate; int compact;
    __device__ __forceinline__ void operator()(const f32x4 (&acc)[2][2][4][2], const Unit& u, int wr, int wc, int fr, int fq) const {
        const int b = compact ? (u.pm >> 4) : u.pm / 17, tt = compact ? (u.pm & 15) : u.pm - b * 17; const bool lat = tt < 16;
        const float* sp = lat ? srclat + (size_t)(b * SEQL + tt * 256) * DM : srcctx + (size_t)(b * CTXL) * DM;
        float* dp = lat ? dstlat + (size_t)(b * SEQL + tt * 256) * DM : dstctx + (size_t)(b * CTXL) * DM;
        const float* gp = gate + (size_t)(lat ? b : 4) * MODW;
#pragma unroll
        for (int bj = 0; bj < 2; ++bj)
#pragma unroll
            for (int n = 0; n < 2; ++n) { const int col = u.pn * BM + bj * HALF + wc * 32 + n * 16 + 4 * fq; const f32x4 gv = *(const f32x4*)(gp + col);
#pragma unroll
                for (int ai = 0; ai < 2; ++ai)
#pragma unroll
                    for (int m = 0; m < 4; ++m) { const size_t off = (size_t)(ai * HALF + wr * 64 + m * 16 + fr) * DM + col;
                        const f32x4 xv = *(const f32x4*)(sp + off); *(f32x4*)(dp + off) = xv * DN_ALPHA + gv * acc[ai][bj][m][n]; } }
    }
};
}

__device__ __forceinline__ int win_src_col(int n0) {
    if (n0 < 256) return n0;
    if (n0 < 640) return 512 + (n0 - 256);
    if (n0 < 1024) return 2304 + (n0 - 640);
    if (n0 < 1280) return 256 + (n0 - 1024);
    if (n0 < 1408) return 896 + (n0 - 1280);
    if (n0 < 1536) return 1024 + (n0 - 1408);
    if (n0 < 2688) return 1152 + (n0 - 1536);
    return n0;
}
__device__ __forceinline__ void transpose_item(const float* W, int K, int Nsrc, int Npad, bf16_t* WT, float* scr, int item, int lane, bool perm) {
    const int nblk = Npad / 32, kb = item / nblk, nb = item - kb * nblk, k0 = 64 * kb, n0 = 32 * nb;
    const int sn = (perm ? win_src_col(n0) : n0) + (lane & 31);
    const bool ok = sn < Nsrc;
    float tv[32];
#pragma unroll
    for (int i = 0; i < 32; ++i) { const int kk = 2 * i + (lane >> 5); tv[i] = ok ? W[(size_t)(k0 + kk) * Nsrc + sn] : 0.f; }
#pragma unroll
    for (int i = 0; i < 32; ++i) { const int kk = 2 * i + (lane >> 5); scr[kk * 33 + (lane & 31)] = tv[i]; }
    __builtin_amdgcn_s_waitcnt(0); asm volatile("" ::: "memory");
    const int c = lane & 7;
#pragma unroll
    for (int j = 0; j < 4; ++j) { const int n = (lane >> 3) + 8 * j; const float* s = scr + (8 * c) * 33 + n;
        u32x4 o; o.x = pk2(s[0 * 33], s[1 * 33]); o.y = pk2(s[2 * 33], s[3 * 33]); o.z = pk2(s[4 * 33], s[5 * 33]); o.w = pk2(s[6 * 33], s[7 * 33]);
        *(u32x4*)(WT + (size_t)(n0 + n) * K + k0 + 8 * c) = o; }
    __builtin_amdgcn_s_waitcnt(0); asm volatile("" ::: "memory");
}

struct Args { const float* in[24]; float* out; unsigned char* ws; };

__device__ __forceinline__ void phase_prologue(const Args& a, unsigned char* lds, int tid, int lane, int wave, int G) {
    float* sc = (float*)lds;
    float* red = (float*)(lds + 20480);
    const float* c = a.in[1]; const float* cctx = a.in[3]; const float* mod_w = a.in[4]; const float* mod_b = a.in[5];
    float* modv = (float*)(a.ws + WS_MODV);
    for (int i = tid; i < 5120; i += NTHR) { const float v = i < 4096 ? c[i] : cctx[i - 4096]; sc[i] = v / (1.0f + expf(-v)); }
    __syncthreads();
    for (int it = blockIdx.x; it < 192; it += G) {
        const int l = it / 96, cb = it - l * 96, col = cb * 64 + lane, k0 = wave * 128;
        const float* W = mod_w + (size_t)l * 1024 * MODW + col;
        float acc0 = 0.f, acc1 = 0.f, acc2 = 0.f, acc3 = 0.f, acc4 = 0.f;
#pragma unroll 16
        for (int k = 0; k < 128; ++k) { const float wv = W[(size_t)(k0 + k) * MODW];
            acc0 += sc[k0 + k] * wv; acc1 += sc[1024 + k0 + k] * wv; acc2 += sc[2048 + k0 + k] * wv; acc3 += sc[3072 + k0 + k] * wv; acc4 += sc[4096 + k0 + k] * wv; }
        red[(wave * 5 + 0) * 64 + lane] = acc0; red[(wave * 5 + 1) * 64 + lane] = acc1; red[(wave * 5 + 2) * 64 + lane] = acc2; red[(wave * 5 + 3) * 64 + lane] = acc3; red[(wave * 5 + 4) * 64 + lane] = acc4;
        __syncthreads();
        if (tid < 320) { const int s = tid >> 6, ln = tid & 63; float sum = 0.f;
#pragma unroll
            for (int w = 0; w < 8; ++w) sum += red[(w * 5 + s) * 64 + ln];
            modv[(size_t)(l * 5 + s) * MODW + cb * 64 + ln] = sum + mod_b[(size_t)l * MODW + cb * 64 + ln]; }
        __syncthreads();
    }
    float* scr = (float*)(lds + 32768 + wave * 8704);
    const int gw = blockIdx.x * NWV + wave, NGW = G * NWV;
    constexpr int I_IN = 16 * 88, I_OUT = 16 * 32, I_UP = 16 * 128, I_DN = 64 * 32, I_L = I_IN + I_OUT + I_UP + I_DN;
    for (int it = gw; it < 2 * I_L; it += NGW) {
        const int l = it / I_L; int r = it - l * I_L; unsigned char* wb = a.ws + WS_W + (size_t)l * W_LAYER;
        if (r < I_IN) { transpose_item(a.in[6] + (size_t)l * 1024 * INC, 1024, INC, 2816, (bf16_t*)(wb + W_IN_OFF), scr, r, lane, true); continue; } r -= I_IN;
        if (r < I_OUT) { transpose_item(a.in[7] + (size_t)l * 1024 * 1024, 1024, 1024, 1024, (bf16_t*)(wb + W_OUT_OFF), scr, r, lane, false); continue; } r -= I_OUT;
        if (r < I_UP) { transpose_item(a.in[22] + (size_t)l * 1024 * DFF, 1024, DFF, DFF, (bf16_t*)(wb + W_UP_OFF), scr, r, lane, false); continue; } r -= I_UP;
        transpose_item(a.in[23] + (size_t)l * DFF * 1024, DFF, 1024, 1024, (bf16_t*)(wb + W_DN_OFF), scr, r, lane, false);
    }
}

template <int MODE>
__device__ __forceinline__ void ln_rows(const float* srclat, const float* srcctx, float* dstlat, float* dstctx, const float* lng, const float* lnb,
                                        const float* modsh  , bf16_t* XN, bool wantxn, bool latonly,
                                        int lane, int wave, int G) {
    const int gw = blockIdx.x * NWV + wave, NGW = G * NWV;
    constexpr int RB = 4;
    for (int rb = gw; rb < NROW; rb += NGW * RB) {
        f32x4 v[RB][4]; size_t ro[RB]; bool lat[RB], act[RB]; int bsrc[RB];
#pragma unroll
        for (int q = 0; q < RB; ++q) { const int r = rb + q * NGW; const int b = r / ROWB, t = r - b * ROWB; lat[q] = t < SEQL; act[q] = r < NROW && !(latonly && !lat[q]); bsrc[q] = lat[q] ? b : 4;
            ro[q] = lat[q] ? (size_t)(b * SEQL + t) * DM : (size_t)(b * CTXL + t - SEQL) * DM;
            if (act[q]) { const float* src = (lat[q] ? srclat : srcctx) + ro[q];
#pragma unroll
                for (int j = 0; j < 4; ++j) v[q][j] = *(const f32x4*)(src + lane * 4 + 256 * j); }
            else {
#pragma unroll
                for (int j = 0; j < 4; ++j) v[q][j] = (f32x4){0.f, 0.f, 0.f, 0.f}; } }
#pragma unroll
        for (int q = 0; q < RB; ++q) { if (!act[q]) continue;
            const int r = rb + q * NGW;
            if (MODE == 1) {
                float s = 0.f;
#pragma unroll
                for (int j = 0; j < 4; ++j) s += (v[q][j][0] + v[q][j][1]) + (v[q][j][2] + v[q][j][3]);
                const float mean = wave_sum(s) * (1.0f / DM); float qq = 0.f;
#pragma unroll
                for (int j = 0; j < 4; ++j) { v[q][j] = v[q][j] - mean; qq += (v[q][j][0] * v[q][j][0] + v[q][j][1] * v[q][j][1]) + (v[q][j][2] * v[q][j][2] + v[q][j][3] * v[q][j][3]); }
                const float rstd = 1.0f / sqrtf(wave_sum(qq) * (1.0f / DM) + LN_EPS);
                float* dst = (lat[q] ? dstlat : dstctx) + ro[q];
#pragma unroll
                for (int j = 0; j < 4; ++j) { const f32x4 g = *(const f32x4*)(lng + lane * 4 + 256 * j), bb = *(const f32x4*)(lnb + lane * 4 + 256 * j);
                    v[q][j] = v[q][j] * rstd * g + bb; *(f32x4*)(dst + lane * 4 + 256 * j) = v[q][j]; }
            }
            if (wantxn) {
                float s = 0.f;
#pragma unroll
                for (int j = 0; j < 4; ++j) s += (v[q][j][0] + v[q][j][1]) + (v[q][j][2] + v[q][j][3]);
                const float mean = wave_sum(s) * (1.0f / DM); float qq = 0.f;
#pragma unroll
                for (int j = 0; j < 4; ++j) { v[q][j] = v[q][j] - mean; qq += (v[q][j][0] * v[q][j][0] + v[q][j][1] * v[q][j][1]) + (v[q][j][2] * v[q][j][2] + v[q][j][3] * v[q][j][3]); }
                const float rstd = 1.0f / sqrtf(wave_sum(qq) * (1.0f / DM) + LN_EPS);
                const float* sh = modsh + (size_t)bsrc[q] * MODW;
                bf16_t* xo = XN + (size_t)r * DM;
#pragma unroll
                for (int j = 0; j < 4; ++j) { const f32x4 shv = *(const f32x4*)(sh + lane * 4 + 256 * j), scv = *(const f32x4*)(sh + 1024 + lane * 4 + 256 * j);
                    const f32x4 o = v[q][j] * rstd * (scv + 1.0f) + shv; u32x2 w; w.x = pk2(o[0], o[1]); w.y = pk2(o[2], o[3]);
                    *(u32x2*)(xo + lane * 4 + 256 * j) = w; }
            }
        }
    }
}

#ifndef PROBE_K
#define PROBE_K -1
#endif
#define SUBSTAMP(k, wsp, cond) do { if (PROBE_K == (k) && (cond) && blockIdx.x == 0 && threadIdx.x == 0) { const unsigned long long t1_ = __builtin_amdgcn_s_memrealtime(); const unsigned long long d_ = (t1_ - *(volatile unsigned long long*)((wsp) + 255 * MiB + 8)) * 8; while (__builtin_amdgcn_s_memrealtime() - t1_ < d_) __builtin_amdgcn_s_sleep(8); } } while (0)
#define BSTAMP(k, wsp, blk, slot, cond) do { if (PROBE_K == (k) && (cond) && blockIdx.x == (blk) && threadIdx.x == 0) { const unsigned long long t1_ = __builtin_amdgcn_s_memrealtime(); const unsigned long long d_ = (t1_ - *(volatile unsigned long long*)((wsp) + 255 * MiB + (slot))) * 8; while (__builtin_amdgcn_s_memrealtime() - t1_ < d_) __builtin_amdgcn_s_sleep(8); } } while (0)
#define BSTART(wsp, blk, slot, cond) do { if (PROBE_K >= 30 && (cond) && blockIdx.x == (blk) && threadIdx.x == 0) *(volatile unsigned long long*)((wsp) + 255 * MiB + (slot)) = __builtin_amdgcn_s_memrealtime(); } while (0)
__device__ __forceinline__ void gmlp_item(int ci, bf16_t* P, const float* ln_g, const float* ln_b, const float* w_s, const float* b_s, unsigned char* lds, int tid, int lane, int wave) {
    bf16_t* tile = (bf16_t*)lds;
    bf16_t* vT = (bf16_t*)(lds + 67584);
    float* st = (float*)(lds + 137216);
    const int r0 = ci * 128, lr = lane & 15, lq = lane >> 4;
    u32x4 uu[8];
    { u32x4 vv[8];
#pragma unroll
      for (int k = 0; k < 8; ++k) { const int p = tid + NTHR * k, row = p >> 5, cp = p & 31; const bf16_t* src = P + (size_t)(r0 + row) * PP + cp * 8;
          vv[k] = *(const u32x4*)(src + PC_GV); uu[k] = *(const u32x4*)(src + PC_U); }
#pragma unroll
      for (int k = 0; k < 8; ++k) { const int p = tid + NTHR * k, row = p >> 5, cp = p & 31; *(u32x4*)(tile + row * 264 + cp * 8) = vv[k]; } }
    f32x4 aw[4][8];
#pragma unroll
    for (int g = 0; g < 4; ++g)
#pragma unroll
        for (int kk = 0; kk < 4; ++kk) { const float* wp = w_s + (size_t)(g * 128 + wave * 16 + lr) * 128 + kk * 32 + lq * 8;
            aw[g][2 * kk] = *(const f32x4*)wp; aw[g][2 * kk + 1] = *(const f32x4*)(wp + 4); }
    float bsv[4][4];
#pragma unroll
    for (int g = 0; g < 4; ++g)
#pragma unroll
        for (int jx = 0; jx < 4; ++jx) bsv[g][jx] = b_s[g * 128 + wave * 16 + lq * 4 + jx];
    __syncthreads();
    for (int t4 = 0; t4 < 4; ++t4) { float x[4][4], mean[4];
#pragma unroll
        for (int q = 0; q < 4; ++q) { const int tk = wave * 16 + t4 * 4 + q; const u32x2 w = *(const u32x2*)(tile + tk * 264 + lane * 4);
            x[q][0] = gelu_f(bf2f(w.x & 0xffffu)); x[q][1] = gelu_f(bf2f(w.x >> 16)); x[q][2] = gelu_f(bf2f(w.y & 0xffffu)); x[q][3] = gelu_f(bf2f(w.y >> 16));
            mean[q] = (x[q][0] + x[q][1]) + (x[q][2] + x[q][3]); }
#pragma unroll
        for (int o = 1; o < 64; o <<= 1)
#pragma unroll
            for (int q = 0; q < 4; ++q) mean[q] += __shfl_xor(mean[q], o);
        float var[4];
#pragma unroll
        for (int q = 0; q < 4; ++q) { mean[q] *= (1.0f / 256.0f); const float d0 = x[q][0] - mean[q], d1 = x[q][1] - mean[q], d2 = x[q][2] - mean[q], d3 = x[q][3] - mean[q]; var[q] = (d0 * d0 + d1 * d1) + (d2 * d2 + d3 * d3); }
#pragma unroll
        for (int o = 1; o < 64; o <<= 1)
#pragma unroll
            for (int q = 0; q < 4; ++q) var[q] += __shfl_xor(var[q], o);
        if (lane == 0) {
#pragma unroll
            for (int q = 0; q < 4; ++q) { const int tk = wave * 16 + t4 * 4 + q; st[tk * 2] = mean[q]; st[tk * 2 + 1] = 1.0f / sqrtf(var[q] * (1.0f / 256.0f) + LN_EPS); } } }
    __syncthreads();
    for (int k = 0; k < 32; ++k) { const int idx = tid + NTHR * k, sx = idx & 127, c = (idx >> 7) * 2;
        const unsigned w = *(const unsigned*)(tile + sx * 264 + c);
        const float mean = st[2 * sx], rstd = st[2 * sx + 1];
        const float y0 = (gelu_f(bf2f(w & 0xffffu)) - mean) * rstd * ln_g[c] + ln_b[c];
        const float y1 = (gelu_f(bf2f(w >> 16)) - mean) * rstd * ln_g[c + 1] + ln_b[c + 1];
        vT[c * 136 + sx] = (bf16_t)f2bf(y0); vT[(c + 1) * 136 + sx] = (bf16_t)f2bf(y1); }
    __syncthreads();
#pragma unroll
    for (int k = 0; k < 8; ++k) { const int p = tid + NTHR * k, row = p >> 5, cp = p & 31; *(u32x4*)(tile + row * 264 + cp * 8) = uu[k]; }
    f32x4 acc[4][4];
#pragma unroll
    for (int g = 0; g < 4; ++g) {
        bf16x8 Af[4];
#pragma unroll
        for (int kk = 0; kk < 4; ++kk) { const f32x4 a0 = aw[g][2 * kk], a1 = aw[g][2 * kk + 1];
            u32x4 w; w.x = pk2(a0[0], a0[1]); w.y = pk2(a0[2], a0[3]); w.z = pk2(a1[0], a1[1]); w.w = pk2(a1[2], a1[3]); Af[kk] = __builtin_bit_cast(bf16x8, w); }
#pragma unroll
        for (int nt = 0; nt < 4; ++nt) { acc[g][nt] = (f32x4){0.f, 0.f, 0.f, 0.f};
#pragma unroll
            for (int kk = 0; kk < 4; ++kk) { const bf16x8 bfr = *(const bf16x8*)(vT + (g * 64 + 16 * nt + lr) * 136 + kk * 32 + lq * 8);
                acc[g][nt] = __builtin_amdgcn_mfma_f32_16x16x32_bf16(Af[kk], bfr, acc[g][nt], 0, 0, 0); } } }
    __syncthreads();
#pragma unroll
    for (int g = 0; g < 4; ++g)
#pragma unroll
        for (int jx = 0; jx < 4; ++jx) { const int t = wave * 16 + lq * 4 + jx;
#pragma unroll
            for (int nt = 0; nt < 4; ++nt) { bf16_t* up = tile + t * 264 + g * 64 + 16 * nt + lr;
                *up = (bf16_t)f2bf(gelu_f(bf2f(*up)) * (acc[g][nt][jx] + bsv[g][jx])); } }
    __syncthreads();
#pragma unroll
    for (int k = 0; k < 8; ++k) { const int p = tid + NTHR * k, row = p >> 5, cp = p & 31; *(u32x4*)(P + (size_t)(r0 + row) * PP + PC_U + cp * 8) = *(const u32x4*)(tile + row * 264 + cp * 8); }
    __syncthreads();
}

constexpr float ATT_C2 = 0.125f * 1.4426950408889634f;
__device__ __forceinline__ void attn_prep_item(int item, bf16_t* P, const float* q_g, const float* k_g, int lane, int wave) {
    const int hd = lane >> 3, j = lane & 7; const bool isq = hd < 6;
    const int col = isq ? PC_AQ + hd * 64 + j * 8 : PC_AK + (hd - 6) * 64 + j * 8;
    const float* gp = (isq ? q_g : k_g) + j * 8;
    float gam[8];
#pragma unroll
    for (int e = 0; e < 8; ++e) gam[e] = gp[e];
    for (int rr = 0; rr < 8; ++rr) {
        const int r = item * 64 + wave * 8 + rr, b = r / ROWB, t = r - b * ROWB; const bool lat = t < SEQL;
        bf16_t* p = P + (size_t)r * PP + col;
        float x[8]; unpack8(*(const u32x4*)p, x);
        float ss = 0.f;
#pragma unroll
        for (int e = 0; e < 8; ++e) ss += x[e] * x[e];
        ss += __shfl_xor(ss, 1); ss += __shfl_xor(ss, 2); ss += __shfl_xor(ss, 4);
        const float rs = 1.0f / sqrtf(ss * (1.0f / 64.0f) + LN_EPS);
#pragma unroll
        for (int e = 0; e < 8; ++e) x[e] = x[e] * rs * gam[e];
        if (lat) {
            const float pos = (float)((j >> 2) ? (t & 63) : (t >> 6)); const bool x2lane = (j & 2) != 0;
#pragma unroll
            for (int e = 0; e < 8; ++e) { const int f = (j & 1) * 8 + e;
                const float inv = exp2f(-(float)f * (13.287712379549449f / 16.0f)), ang = pos * inv, rev = ang * 0.15915494309189535f;
                const float cs = __builtin_amdgcn_cosf(rev), sn = __builtin_amdgcn_sinf(rev);
                const float other = __shfl_xor(x[e], 2);
                x[e] = x[e] * cs + (x2lane ? other : -other) * sn; }
        }
        if (isq) {
#pragma unroll
            for (int e = 0; e < 8; ++e) x[e] *= ATT_C2;
        }
        *(u32x4*)p = pack8(x);
    }
}

__device__ __forceinline__ float dpp_xor1(float v) { return __builtin_bit_cast(float, __builtin_amdgcn_update_dpp(0, __builtin_bit_cast(int, v), 0xB1, 0xF, 0xF, true)); }
__device__ __forceinline__ void dn_chunk_item(int ck, int h, const bf16_t* P, const float* AB, const float* conv_w, const float* a_log, const float* dt_bias,
                                              unsigned char* ws, unsigned char* lds, int tid_in, int lane_in, bool probe) {
    int tid = tid_in; asm volatile("" : "+v"(tid));
    const int lane = tid & 63, wave = __builtin_amdgcn_readfirstlane(tid >> 6);
    float* raw = (float*)lds;
    float* Lp = (float*)lds;
    bf16_t* qb = (bf16_t*)(lds + 32768); bf16_t* kb = (bf16_t*)(lds + 41984);
    float* qkv = (float*)(lds + 52224);
    float* KKs = (float*)(lds + 102144);
    float* QKs = (float*)(lds + 118784);
    float* gcs = (float*)(lds + 135424);
    const int r0 = ck * 64, b = r0 / ROWB, t0 = r0 - b * ROWB;
    const int seg_lo = b * ROWB + (t0 < SEQL ? 0 : SEQL), seg_hi = b * ROWB + (t0 < SEQL ? SEQL : ROWB);
    float cw[3][5];
#pragma unroll
    for (int m = 0; m < 3; ++m)
#pragma unroll
        for (int jj = 0; jj < 5; ++jj) cw[m][jj] = conv_w[jj * 1152 + m * 384 + h * 64 + (tid & 63)];
    for (int pc = tid; pc < 1632; pc += NTHR) { const int m = pc / 544, rem = pc - m * 544, rr = rem >> 3, ch = rem & 7, row = r0 - 2 + rr;
        float f[8];
#pragma unroll
        for (int e = 0; e < 8; ++e) f[e] = 0.f;
        if (row >= seg_lo && row < seg_hi) unpack8(*(const u32x4*)(P + (size_t)row * PP + PC_DQ + m * 384 + h * 64 + ch * 8), f);
        float* d = raw + (m * 68 + rr) * 64 + ch * 8;
        *(f32x4*)d = (f32x4){f[0], f[1], f[2], f[3]}; *(f32x4*)(d + 4) = (f32x4){f[4], f[5], f[6], f[7]}; }
    __syncthreads();
#pragma unroll
    for (int k = 0; k < 24; ++k) { const int m = k >> 3, i = (tid >> 6) + 8 * (k & 7), d = tid & 63; float s = 0.f;
#pragma unroll
        for (int jj = 0; jj < 5; ++jj) s += cw[m][jj] * raw[(m * 68 + i + jj) * 64 + d];
        qkv[(m * 64 + i) * 65 + d] = silu_f(s); }
    __syncthreads();
    { const int row = tid >> 2, part = tid & 3; float* p = qkv + row * 65 + part * 16; float ss = 0.f;
        float x[16];
#pragma unroll
        for (int e = 0; e < 16; ++e) { x[e] = p[e]; ss += x[e] * x[e]; }
        ss += __shfl_xor(ss, 1); ss += __shfl_xor(ss, 2);
        const float scl = (1.0f / sqrtf(ss + LN_EPS)) * (row < 64 ? 0.125f : 1.0f);
#pragma unroll
        for (int e = 0; e < 16; ++e) { x[e] *= scl; p[e] = x[e]; }
        bf16_t* bp = (row < 64 ? qb : kb) + (row & 63) * 72 + part * 16;
        u32x4 w0, w1; w0.x = pk2(x[0], x[1]); w0.y = pk2(x[2], x[3]); w0.z = pk2(x[4], x[5]); w0.w = pk2(x[6], x[7]);
        w1.x = pk2(x[8], x[9]); w1.y = pk2(x[10], x[11]); w1.z = pk2(x[12], x[13]); w1.w = pk2(x[14], x[15]);
        *(u32x4*)bp = w0; *(u32x4*)(bp + 8) = w1; }
    __syncthreads();
    unsigned char* shp = ws + WS_DNSH + (size_t)(ck * 6 + h) * 16384;
    { const int rw = tid >> 3, c0 = (tid & 7) * 8; float f[8];
#pragma unroll
        for (int e = 0; e < 8; ++e) f[e] = qkv[rw * 65 + c0 + e];
        *(u32x4*)(shp + (size_t)(rw * 64 + c0) * 2) = pack8(f);
#pragma unroll
        for (int e = 0; e < 8; ++e) f[e] = qkv[(64 + c0 + e) * 65 + rw];
        *(u32x4*)(shp + 8192 + (size_t)(rw * 64 + c0) * 2) = pack8(f); }
    SUBSTAMP(31, ws, probe);
    { const int mat = wave >> 2, mt = wave & 3, lr = lane & 15, lq = lane >> 4;
        const bf16_t* Ab = (mat ? qb : kb) + (16 * mt + lr) * 72 + lq * 8;
        const bf16x8 a0 = *(const bf16x8*)Ab, a1 = *(const bf16x8*)(Ab + 32);
        float* Op = (mat ? QKs : KKs) + (16 * mt + lq * 4) * 65 + lr;
#pragma unroll
        for (int nt = 0; nt < 4; ++nt) { const bf16_t* Bb = kb + (16 * nt + lr) * 72 + lq * 8;
            f32x4 acc = (f32x4){0.f, 0.f, 0.f, 0.f};
            acc = __builtin_amdgcn_mfma_f32_16x16x32_bf16(a0, *(const bf16x8*)Bb, acc, 0, 0, 0);
            acc = __builtin_amdgcn_mfma_f32_16x16x32_bf16(a1, *(const bf16x8*)(Bb + 32), acc, 0, 0, 0);
#pragma unroll
            for (int jx = 0; jx < 4; ++jx) Op[jx * 65 + 16 * nt] = acc[jx]; } }
    const int dir = tid >> 8, lt = tid & 255;
    if (lt < 64) { const int i = lt, tok = dir ? 63 - i : i; const float* ab = AB + (size_t)(r0 + tok) * 24;
        const float x = ab[dir * 6 + h] + dt_bias[dir * 6 + h];
        const float sp = fmaxf(x, 0.f) + log1pf(expf(-fabsf(x)));
        float g = -expf(a_log[dir * 6 + h]) * sp;
        const float beta = 1.0f / (1.0f + expf(-ab[12 + dir * 6 + h]));
#pragma unroll
        for (int o = 1; o < 64; o <<= 1) { const float tv = __shfl_up(g, o); if (lane >= o) g += tv; }
        gcs[dir * 64 + i] = g; gcs[128 + dir * 64 + i] = beta; gcs[256 + dir * 64 + i] = expf(g); }
    __syncthreads();
    const float* gc = gcs + dir * 64; const float* bt = gcs + 128 + dir * 64; const float* eg = gcs + 256 + dir * 64;
    const int itd = (ck * 6 + h) * 2 + dir;
    unsigned char* pd = ws + WS_DNPD + (size_t)itd * 24576;
    { float* Ld = Lp + dir * 4096;
#pragma unroll 4
        for (int k = 0; k < 16; ++k) { const int e = lt + 256 * k, i = e >> 6, jx = e & 63, ti = dir ? 63 - i : i, tj = dir ? 63 - jx : jx;
            Ld[i * 64 + (jx & 1) * 32 + (jx >> 1)] = (i > jx) ? bt[i] * KKs[ti * 65 + tj] * expf(gc[i] - gc[jx]) : 0.f; }
        const int i = lt >> 2, j0 = (lt & 3) * 16, ti = dir ? 63 - i : i;
        bf16_t* ip = (bf16_t*)(pd + 16384) + i * 64 + j0;
#pragma unroll
        for (int q8 = 0; q8 < 2; ++q8) { float f[8];
#pragma unroll
            for (int e = 0; e < 8; ++e) { const int jx = j0 + q8 * 8 + e, tj = dir ? 63 - jx : jx; f[e] = (i >= jx) ? QKs[ti * 65 + tj] * expf(gc[i] - gc[jx]) : 0.f; }
            *(u32x4*)(ip + q8 * 8) = pack8(f); }
        float* vec = (float*)(ws + WS_DNVEC) + (size_t)itd * 192;
        if (lt < 64) { vec[lt] = eg[lt]; vec[64 + lt] = expf(gc[63] - gc[lt]); if (lt == 0) vec[128] = eg[63]; } }
    __syncthreads();
    SUBSTAMP(32, ws, probe);
    {
        const int c = lt >> 1, par = lt & 1, cc = c & 63; const bool isv = c < 64;
        const float* rp = qkv + (isv ? 128 : 64) * 65 + cc;
        const float* Lrow = Lp + dir * 4096 + par * 32;
        float sp[32];
#pragma unroll
        for (int m = 0; m < 32; ++m) sp[m] = 0.f;
#pragma unroll
        for (int i = 0; i < 64; ++i) { const int ti = dir ? 63 - i : i;
            float rhs = rp[ti * 65] * bt[i]; if (!isv) rhs *= eg[i];
            float acc0 = 0.f, acc1 = 0.f;
#pragma unroll
            for (int jj = 0; jj < (i + 1) / 2; ++jj) { if (jj & 1) acc1 += Lrow[i * 64 + jj] * sp[jj]; else acc0 += Lrow[i * 64 + jj] * sp[jj]; }
            float acc = acc0 + acc1; acc += dpp_xor1(acc);
            float si = rhs - acc;
            if ((i & 3) == 3) asm volatile("" : "+v"(si) :: "memory"); else asm volatile("" : "+v"(si));
            sp[i >> 1] = ((i & 1) == par) ? si : sp[i >> 1]; }
        if (isv) { unsigned dw[16];
#pragma unroll
            for (int q = 0; q < 16; ++q) { float lo = sp[q], hi = sp[16 + q]; asm volatile("" : "+v"(lo), "+v"(hi));
                const float mine = par ? hi : lo, send = par ? lo : hi, recv = dpp_xor1(send);
                dw[q] = par ? pk2(recv, mine) : pk2(mine, recv); }
            bf16_t* uT = (bf16_t*)pd + cc * 64 + par * 32;
#pragma unroll
            for (int q4 = 0; q4 < 4; ++q4) { u32x4 w; w.x = dw[q4 * 4]; w.y = dw[q4 * 4 + 1]; w.z = dw[q4 * 4 + 2]; w.w = dw[q4 * 4 + 3]; *(u32x4*)(uT + q4 * 8) = w; } }
        else { bf16_t* wp = (bf16_t*)(pd + 8192) + par * 64 + cc;
#pragma unroll
            for (int m = 0; m < 32; ++m) wp[m * 128] = (bf16_t)f2bf(sp[m]); }
    }
    __syncthreads();
    SUBSTAMP(33, ws, probe);
}

struct ScanIn { bf16x8 Aw[2], Aq[2], Ai[2], Ak[2]; u32x2 U[2]; f32x4 egc4, ekd4; float egl; int r0; };
__device__ __forceinline__ void scan_load(ScanIn& in, int s, int b, int h, int dir, const unsigned char* ws, int rowA, int tokA, int c4, int ni0, int lr, int lq) {
    const int ckl = dir ? 67 - s : (s < 4 ? 64 + s : s - 4);
    const int ck = b * 68 + ckl, it = ck * 6 + h, itd = it * 2 + dir;
    const unsigned char* shp = ws + WS_DNSH + (size_t)it * 16384;
    const unsigned char* pd = ws + WS_DNPD + (size_t)itd * 24576;
    const float* vec = (const float*)(ws + WS_DNVEC) + (size_t)itd * 192;
    in.r0 = ck * 64;
#pragma unroll
    for (int kk = 0; kk < 2; ++kk) {
        in.Aw[kk] = *(const bf16x8*)(pd + 8192 + (size_t)(rowA * 64 + kk * 32 + lq * 8) * 2);
        in.Aq[kk] = *(const bf16x8*)(shp + (size_t)(tokA * 64 + kk * 32 + lq * 8) * 2);
        in.Ai[kk] = *(const bf16x8*)(pd + 16384 + (size_t)(rowA * 64 + kk * 32 + lq * 8) * 2);
        in.Ak[kk] = *(const bf16x8*)(shp + 8192 + (size_t)(rowA * 64 + kk * 32 + lq * 8) * 2); }
#pragma unroll
    for (int n = 0; n < 2; ++n) in.U[n] = *(const u32x2*)(pd + (size_t)((16 * (ni0 + n) + lr) * 64 + c4) * 2);
    in.egc4 = *(const f32x4*)(vec + c4); in.ekd4 = *(const f32x4*)(vec + 64 + c4); in.egl = vec[128];
}
__device__ __forceinline__ void scan_step(const ScanIn& in, f32x4 (&Sacc)[2], int& cur, bf16_t* ST, bf16_t* vnT, bf16_t* vnT2, bf16_t* Ot, bf16_t* P, int ocol, int prev_r0,
                                          int dir, int tid, int ni0, int lr, int lq, int c4) {
#define SCAN_BAR() do { asm volatile("s_waitcnt lgkmcnt(0)" ::: "memory"); __builtin_amdgcn_s_barrier(); asm volatile("" ::: "memory"); } while (0)
    bf16x8 BS[2][2];
#pragma unroll
    for (int n = 0; n < 2; ++n)
#pragma unroll
        for (int kk = 0; kk < 2; ++kk) BS[n][kk] = *(const bf16x8*)(ST + cur * 4608 + (16 * (ni0 + n) + lr) * 72 + kk * 32 + lq * 8);
    if (prev_r0 >= 0) { const int row = tid >> 3, pc = tid & 7; *(u32x4*)(P + (size_t)(prev_r0 + row) * PP + ocol + pc * 8) = *(const u32x4*)(Ot + row * 72 + pc * 8); }
#pragma unroll
    for (int n = 0; n < 2; ++n) { f32x4 acc = (f32x4){0.f, 0.f, 0.f, 0.f};
        acc = __builtin_amdgcn_mfma_f32_16x16x32_bf16(in.Aw[0], BS[n][0], acc, 0, 0, 0); acc = __builtin_amdgcn_mfma_f32_16x16x32_bf16(in.Aw[1], BS[n][1], acc, 0, 0, 0);
        const float v0 = bf2f(in.U[n].x & 0xffffu) - acc[0], v1 = bf2f(in.U[n].x >> 16) - acc[1], v2 = bf2f(in.U[n].y & 0xffffu) - acc[2], v3 = bf2f(in.U[n].y >> 16) - acc[3];
        const int vrow = (16 * (ni0 + n) + lr) * 72;
        u32x2 w; w.x = pk2(v0, v1); w.y = pk2(v2, v3); *(u32x2*)(vnT + vrow + c4) = w;
        const float s0 = v0 * in.ekd4[0], s1 = v1 * in.ekd4[1], s2 = v2 * in.ekd4[2], s3 = v3 * in.ekd4[3];
        if (dir == 0) { w.x = pk2(s0, s1); w.y = pk2(s2, s3); *(u32x2*)(vnT2 + vrow + c4) = w; }
        else { w.x = pk2(s3, s2); w.y = pk2(s1, s0); *(u32x2*)(vnT2 + vrow + 60 - c4) = w; } }
    SCAN_BAR();
#pragma unroll
    for (int n = 0; n < 2; ++n) { f32x4 acc = (f32x4){0.f, 0.f, 0.f, 0.f};
        acc = __builtin_amdgcn_mfma_f32_16x16x32_bf16(in.Aq[0], BS[n][0], acc, 0, 0, 0); acc = __builtin_amdgcn_mfma_f32_16x16x32_bf16(in.Aq[1], BS[n][1], acc, 0, 0, 0);
        acc = acc * in.egc4;
        const int vrow = (16 * (ni0 + n) + lr) * 72;
        const bf16x8 bv0 = *(const bf16x8*)(vnT + vrow + lq * 8), bv1 = *(const bf16x8*)(vnT + vrow + 32 + lq * 8);
        acc = __builtin_amdgcn_mfma_f32_16x16x32_bf16(in.Ai[0], bv0, acc, 0, 0, 0); acc = __builtin_amdgcn_mfma_f32_16x16x32_bf16(in.Ai[1], bv1, acc, 0, 0, 0);
#pragma unroll
        for (int jx = 0; jx < 4; ++jx) { const int c = c4 + jx, tok = dir ? 63 - c : c; Ot[tok * 72 + 16 * (ni0 + n) + lr] = (bf16_t)f2bf(acc[jx]); }
        const bf16x8 b20 = *(const bf16x8*)(vnT2 + vrow + lq * 8), b21 = *(const bf16x8*)(vnT2 + vrow + 32 + lq * 8);
        f32x4 sa = Sacc[n] * in.egl;
        sa = __builtin_amdgcn_mfma_f32_16x16x32_bf16(in.Ak[0], b20, sa, 0, 0, 0); sa = __builtin_amdgcn_mfma_f32_16x16x32_bf16(in.Ak[1], b21, sa, 0, 0, 0);
        Sacc[n] = sa;
        u32x2 w; w.x = pk2(sa[0], sa[1]); w.y = pk2(sa[2], sa[3]); *(u32x2*)(ST + (cur ^ 1) * 4608 + vrow + c4) = w; }
    cur ^= 1;
    SCAN_BAR();
}
__device__ __forceinline__ void dn_scan_unit(int b, int h, int dir, bf16_t* P, const unsigned char* ws, unsigned char* lds, int tid, int lane, int wave) {
    bf16_t* ST = (bf16_t*)lds;
    bf16_t* vnT = ST + 2 * 4608;
    bf16_t* vnT2 = vnT + 4608;
    bf16_t* Ot = vnT2 + 4608;
    for (int i = tid; i < 5 * 4608 / 2; i += NTHR) ((unsigned*)lds)[i] = 0u;
    __syncthreads();
    const int mi = wave >> 1, ni0 = (wave & 1) * 2, lr = lane & 15, lq = lane >> 4;
    f32x4 Sacc[2]; Sacc[0] = (f32x4){0.f, 0.f, 0.f, 0.f}; Sacc[1] = Sacc[0];
    int cur = 0;
    const int rowA = 16 * mi + lr, tokA = dir ? 63 - rowA : rowA, c4 = 16 * mi + lq * 4, ocol = (dir ? PC_DK : PC_DQ) + h * 64;
    ScanIn sA, sB, sC, sD;
#define SCAN_LD(SET, sidx) scan_load(SET, (sidx) < 68 ? (sidx) : 67, b, h, dir, ws, rowA, tokA, c4, ni0, lr, lq)
    SCAN_LD(sA, 0); SCAN_LD(sB, 1); SCAN_LD(sC, 2);
    int prev_r0 = -1;
    for (int s = 0; s < 68; s += 4) {
        SCAN_LD(sD, s + 3); scan_step(sA, Sacc, cur, ST, vnT, vnT2, Ot, P, ocol, prev_r0, dir, tid, ni0, lr, lq, c4); prev_r0 = sA.r0;
        SCAN_LD(sA, s + 4); scan_step(sB, Sacc, cur, ST, vnT, vnT2, Ot, P, ocol, prev_r0, dir, tid, ni0, lr, lq, c4); prev_r0 = sB.r0;
        SCAN_LD(sB, s + 5); scan_step(sC, Sacc, cur, ST, vnT, vnT2, Ot, P, ocol, prev_r0, dir, tid, ni0, lr, lq, c4); prev_r0 = sC.r0;
        SCAN_LD(sC, s + 6); scan_step(sD, Sacc, cur, ST, vnT, vnT2, Ot, P, ocol, prev_r0, dir, tid, ni0, lr, lq, c4); prev_r0 = sD.r0;
    }
    { const int row = tid >> 3, pc = tid & 7; *(u32x4*)(P + (size_t)(prev_r0 + row) * PP + ocol + pc * 8) = *(const u32x4*)(Ot + row * 72 + pc * 8); }
    __syncthreads();
#undef SCAN_LD
#undef SCAN_BAR
}

__device__ __forceinline__ void dn_gate_rows(bf16_t* P, const float* norm_g, int lane, int wave, int G) {
    const int gw = blockIdx.x * NWV + wave, NGW = G * NWV; const float ng = norm_g[lane];
    for (int r = gw; r < NROW; r += NGW) { bf16_t* pr = P + (size_t)r * PP;
#pragma unroll
        for (int h = 0; h < 6; ++h) { const float o = bf2f(pr[PC_DQ + h * 64 + lane]) + bf2f(pr[PC_DK + h * 64 + lane]);
            const float ss = wave_sum(o * o); const float z = bf2f(pr[PC_Z + h * 64 + lane]);
            pr[PC_Z + h * 64 + lane] = (bf16_t)f2bf(o * (1.0f / sqrtf(ss * (1.0f / 64.0f) + LN_EPS)) * ng * silu_f(z)); } }
}

#ifndef EN_G1
#define EN_G1 1
#endif
#ifndef EN_G2
#define EN_G2 1
#endif
#ifndef EN_G3
#define EN_G3 1
#endif
#ifndef EN_G4
#define EN_G4 1
#endif
#ifndef EN_PRO
#define EN_PRO 1
#endif
#ifndef EN_GEMM
#define EN_GEMM 1
#endif
#ifndef EN_GMLP
#define EN_GMLP 1
#endif
#ifndef EN_DNC
#define EN_DNC 1
#endif
#ifndef EN_PREP
#define EN_PREP 1
#endif
#ifndef EN_SCAN
#define EN_SCAN 1
#endif
#ifndef EN_ATTN
#define EN_ATTN 1
#endif
#ifndef EN_GATE
#define EN_GATE 1
#endif
#ifndef EN_LN
#define EN_LN 1
#endif
constexpr int LDS_BYTES = 147456;
#ifndef PROBE_K
#define PROBE_K -1
#endif
#ifndef PROBE_MULT
#define PROBE_MULT 1
#endif
#define STAMP(k) do { if (PROBE_K == (k) && blockIdx.x == 0 && threadIdx.x == 0) { const unsigned long long t1_ = __builtin_amdgcn_s_memrealtime(); const unsigned long long d_ = (t1_ - *(volatile unsigned long long*)(a.ws + 255 * MiB)) * PROBE_MULT; while (__builtin_amdgcn_s_memrealtime() - t1_ < d_) __builtin_amdgcn_s_sleep(8); } } while (0)
#define FRESH() do { tid = threadIdx.x; asm volatile("" : "+v"(tid)); lane = tid & 63; wave = __builtin_amdgcn_readfirstlane(tid >> 6); } while (0)
#define FRESHL() do { asm volatile("" : "+s"(l)); wb = ws + WS_W + (size_t)l * W_LAYER; mv = modv + (size_t)l * 5 * MODW; xlat = l == 0 ? a.in[0] : a.out; xctx = l == 0 ? a.in[2] : Xctx; } while (0)
template <int LYR> __device__ __forceinline__ void layer_fwd(const Args& a, unsigned char* lds, cg::grid_group& grid) {
    int tid = threadIdx.x, lane = tid & 63, wave = __builtin_amdgcn_readfirstlane(tid >> 6); const int G = gridDim.x;
    unsigned char* ws = a.ws;
    bf16_t* P = (bf16_t*)(ws + WS_P); bf16_t* XN = (bf16_t*)(ws + WS_XN); bf16_t* H = (bf16_t*)(ws + WS_H);
    float* AB = (float*)(ws + WS_AB); float* Xctx = (float*)(ws + WS_XCTX); float* modv = (float*)(ws + WS_MODV);
    PG8_LAS unsigned char* lds3 = (PG8_LAS unsigned char*)lds;
    int l = LYR;
        const unsigned char* wb; const float* mv; const float* xlat; const float* xctx;
        FRESHL();
        { pg8::Gemm g{XN, (const bf16_t*)(wb + W_IN_OFF), NROW, 2816, 1024, 1024, 0}; pg8::StaticOrder S; S.init(NROW, 2816, G, (int)blockIdx.x);
          pg8::EpiP E{P, AB}; if (EN_GEMM && EN_G1) pg8::gemm_phase<pg8::EpiP, pg8::StaticOrder, true, true>(lds3, g, S, E); }
        grid.sync(); STAMP(2 + 9 * LYR + 0);
        FRESHL();
        if (PROBE_K >= 30 && LYR == 0 && blockIdx.x == 0 && threadIdx.x == 0) *(volatile unsigned long long*)(ws + 255 * MiB + 8) = __builtin_amdgcn_s_memrealtime();
        BSTART(ws, 96, 24, LYR == 0);
        for (int it = blockIdx.x; it < 1632 + 272; it += G) { FRESH();
            BSTAMP(42, ws, 96, 24, LYR == 0 && it == 1632);
            BSTAMP(41, ws, 96, 24, LYR == 0 && it == 1888);
            if (it < 1632) { const int q = it; if (EN_DNC) dn_chunk_item(q / 6, q % 6, P, AB, a.in[14] + (size_t)l * 5 * 1152, a.in[15] + l * 12, a.in[16] + l * 12, ws, lds, tid, lane, LYR == 0 && it == 0); }
            else if (EN_PREP) attn_prep_item(it - 1632, P, a.in[12] + l * 64, a.in[13] + l * 64, lane, wave);
        }
        grid.sync(); STAMP(2 + 9 * LYR + 1);
        FRESHL();
        FRESH();
        BSTART(ws, 0, 16, LYR == 0); BSTART(ws, 48, 32, LYR == 0); BSTART(ws, 255, 40, LYR == 0);
        if (blockIdx.x < 48) { const int u = blockIdx.x; if (EN_SCAN) dn_scan_unit(u / 12, (u % 12) >> 1, u & 1, P, ws, lds, tid, lane, wave); BSTAMP(40, ws, 0, 16, LYR == 0); }
        else {
            const int nat = (l == 0) ? 408 : 384;
            if (EN_GMLP) for (int ci = G - 1 - (int)blockIdx.x; ci < 136; ci += G - 48) { FRESH();
                if (LYR != 0 && (ci % 34) >= 32) continue;
                gmlp_item(ci, P, a.in[8] + l * 256, a.in[9] + l * 256, a.in[10] + (size_t)l * 4 * 128 * 128, a.in[11] + l * 512, lds, tid, lane, wave); }
            FRESH();
            if (EN_ATTN) for (int u = blockIdx.x - 48; u < nat; u += G - 48) {
                const attn_body::bf16* Pb = (const attn_body::bf16*)P;
                if (u < 384) { const int b = u / 96, rem = u - b * 96, hq = rem >> 4, qb = rem & 15; const size_t rb = (size_t)b * ROWB;
                    attn_body::attn_unit<8>(Pb + (rb + qb * 256) * PP + PC_AQ + hq * 64, Pb + rb * PP + PC_AK + (hq / 3) * 64, Pb + rb * PP + PC_AV + (hq / 3) * 64,
                                            (attn_body::bf16*)P + (rb + qb * 256) * PP + PC_AQ + hq * 64, 68, (char*)lds); }
                else { const int v = u - 384, b = v / 6, hq = v - b * 6; const size_t rb = (size_t)b * ROWB + SEQL;
                    attn_body::attn_unit<8>(Pb + rb * PP + PC_AQ + hq * 64, Pb + rb * PP + PC_AK + (hq / 3) * 64, Pb + rb * PP + PC_AV + (hq / 3) * 64,
                                            (attn_body::bf16*)P + rb * PP + PC_AQ + hq * 64, 4, (char*)lds); }
            }
            BSTAMP(43, ws, 48, 32, LYR == 0); BSTAMP(44, ws, 255, 40, LYR == 0);
        }
        grid.sync(); STAMP(2 + 9 * LYR + 2);
        FRESHL();
        FRESH(); if (EN_GATE) dn_gate_rows(P, a.in[17] + l * 64, lane, wave, G);
        grid.sync(); STAMP(2 + 9 * LYR + 3);
        FRESHL();
        { constexpr int MR = LYR == 0 ? NROW : NB * SEQL; pg8::Gemm g{P, (const bf16_t*)(wb + W_OUT_OFF), MR, 1024, 1024, PP, LYR != 0}; pg8::StaticOrder S; S.init(MR, 1024, G, (int)blockIdx.x);
          pg8::EpiRes E{xlat, xctx, a.out, Xctx, mv + 2 * 1024, LYR != 0}; if (EN_GEMM && EN_G2) pg8::gemm_phase<pg8::EpiRes, pg8::StaticOrder, true, true>(lds3, g, S, E); }
        grid.sync(); STAMP(2 + 9 * LYR + 4);
        FRESHL();
        FRESH(); if (EN_LN) ln_rows<1>(a.out, Xctx, a.out, Xctx, a.in[18] + l * 1024, a.in[19] + l * 1024, mv + 3 * 1024, XN, true, LYR != 0, lane, wave, G);
        grid.sync(); STAMP(2 + 9 * LYR + 5);
        FRESHL();
        { constexpr int MR = LYR == 0 ? NROW : NB * SEQL; pg8::Gemm g{XN, (const bf16_t*)(wb + W_UP_OFF), MR, DFF, 1024, 1024, LYR != 0}; pg8::StaticOrder S; S.init(MR, DFF, G, (int)blockIdx.x);
          pg8::EpiH E{H}; if (EN_GEMM && EN_G3) pg8::gemm_phase<pg8::EpiH, pg8::StaticOrder, true, true>(lds3, g, S, E); }
        grid.sync(); STAMP(2 + 9 * LYR + 6);
        FRESHL();
        { constexpr int MR = LYR == 0 ? NROW : NB * SEQL; pg8::Gemm g{H, (const bf16_t*)(wb + W_DN_OFF), MR, 1024, DFF, DFF, 0}; pg8::StaticOrder S; S.init(MR, 1024, G, (int)blockIdx.x);
          pg8::EpiRes E{a.out, Xctx, a.out, Xctx, mv + 5 * 1024, LYR != 0}; if (EN_GEMM && EN_G4) pg8::gemm_phase<pg8::EpiRes, pg8::StaticOrder, true, true>(lds3, g, S, E); }
        grid.sync(); STAMP(2 + 9 * LYR + 7);
        FRESHL();
        FRESH(); if (EN_LN) ln_rows<1>(a.out, Xctx, a.out, Xctx, a.in[20] + l * 1024, a.in[21] + l * 1024, modv + (size_t)(l + 1) * 5 * MODW, XN, l + 1 < NLAYER, l + 1 == NLAYER, lane, wave, G);
        if (l + 1 < NLAYER) grid.sync(); STAMP(2 + 9 * LYR + 8);
}

__global__ void __launch_bounds__(NTHR, 2) mega_fwd(Args a) {
    extern __shared__ __attribute__((aligned(16))) unsigned char lds[];
    cg::grid_group grid = cg::this_grid();
    if (PROBE_K >= 0 && blockIdx.x == 0 && threadIdx.x == 0) *(volatile unsigned long long*)(a.ws + 255 * MiB) = __builtin_amdgcn_s_memrealtime();
    {
        int tid = threadIdx.x, lane = tid & 63, wave = __builtin_amdgcn_readfirstlane(tid >> 6); const int G = gridDim.x;
        unsigned char* ws = a.ws;
        bf16_t* P = (bf16_t*)(ws + WS_P); bf16_t* XN = (bf16_t*)(ws + WS_XN); bf16_t* H = (bf16_t*)(ws + WS_H);
        float* AB = (float*)(ws + WS_AB); float* Xctx = (float*)(ws + WS_XCTX); float* modv = (float*)(ws + WS_MODV);
        PG8_LAS unsigned char* lds3 = (PG8_LAS unsigned char*)lds;
#if EN_PRO
        FRESH(); phase_prologue(a, lds, tid, lane, wave, G);
#endif
        grid.sync(); STAMP(0);
        FRESH(); if (EN_LN) ln_rows<0>(a.in[0], a.in[2], nullptr, nullptr, nullptr, nullptr, modv, XN, true, false, lane, wave, G);
        grid.sync(); STAMP(1);
    }
    layer_fwd<0>(a, lds, grid);
    layer_fwd<1>(a, lds, grid);
    STAMP(20);
}

extern "C" void kernel_launch(void* const* d_in, const int* in_sizes, int n_in, void* d_out, int out_size, void* d_ws, size_t ws_size, hipStream_t stream) {
    static int grid = 0;
    if (grid == 0) {
        int dev = 0, cus = 0, per_cu = 0;
        hipGetDevice(&dev);
        hipDeviceGetAttribute(&cus, hipDeviceAttributeMultiprocessorCount, dev);
        if (hipFuncSetAttribute((const void*)mega_fwd, hipFuncAttributeMaxDynamicSharedMemorySize, LDS_BYTES) != hipSuccess) fprintf(stderr, "kernel_launch: hipFuncSetAttribute failed\n");
        if (hipOccupancyMaxActiveBlocksPerMultiprocessor(&per_cu, (const void*)mega_fwd, NTHR, LDS_BYTES) != hipSuccess || per_cu < 1) { fprintf(stderr, "kernel_launch: occupancy query says %d\n", per_cu); per_cu = 1; }
        (void)hipGetLastError();
        grid = cus * 1;
        if (n_in != 24 || ws_size < 254 * MiB) fprintf(stderr, "kernel_launch: unexpected n_in %d / ws %zu\n", n_in, ws_size);
    }
    Args a{};
    for (int i = 0; i < 24; ++i) a.in[i] = (const float*)d_in[i];
    a.out = (float*)d_out; a.ws = (unsigned char*)d_ws;
    void* params[] = {&a};
    hipError_t e = hipLaunchCooperativeKernel((const void*)mega_fwd, dim3(grid), dim3(NTHR), params, LDS_BYTES, stream);
    if (e != hipSuccess) fprintf(stderr, "kernel_launch: cooperative launch failed: %s (grid %d)\n", hipGetErrorString(e), grid);
}
```

```cpp
#include <hip/hip_runtime.h>
#include <hip/hip_cooperative_groups.h>
#include <cstdio>
#include <cstdint>
namespace cg = cooperative_groups;
namespace pg8 {
#define PG8_LAS __attribute__((address_space(3)))
typedef unsigned short bf16_t;
typedef short bf16x8 __attribute__((ext_vector_type(8)));
typedef float f32x4 __attribute__((ext_vector_type(4)));
typedef unsigned u32x4 __attribute__((ext_vector_type(4)));
constexpr int BM = 256, BK = 64, HALF = 128, HTB = HALF * BK * 2  , STAGE_BYTES = 8 * HTB, NXCD = 8, WGM = 8;

__host__ __device__ __forceinline__ int lds_byte(int r, int c) { const int st = (r >> 4) * 2 + (c >> 5), rr = r & 15, cc = c & 31, ob = rr * 64 + cc * 2; return st * 1024 + (ob ^ (((ob >> 9) & 1) << 5)); }
__host__ __device__ __forceinline__ void stage_rc(int b, int& R, int& C) { const int st = b / 1024, sb = b % 1024, swz = sb ^ (((sb >> 9) & 1) << 5); R = (st >> 1) * 16 + swz / 64; C = (st & 1) * 32 + (swz % 64) / 2; }
__host__ __device__ __forceinline__ int perm32(int rho) { const int n = rho >> 4, i = rho & 15; return 8 * (i >> 2) + 4 * n + (i & 3); }

struct Unit { int pm, pn, ko; };
struct Gemm { const bf16_t* A; const bf16_t* Bt; int M, N, K, lda, amap, ldb; };

struct StaticOrder {
    int nM, nN, nwg, G, c;
    __host__ __device__ void init(int M, int N, int G_, int c_) { nM = M / BM; nN = N / BM; nwg = nM * nN; G = G_; c = c_; }
    __host__ __device__ bool next(int i, Unit& u) const {
        const long L = (long)i * G + c; if (L >= nwg) return false;
        int wgid = (int)L; { const int q = nwg / NXCD, r = nwg % NXCD, xcd = wgid % NXCD, off = wgid / NXCD; wgid = (xcd < r ? xcd * (q + 1) : r * (q + 1) + (xcd - r) * q) + off; }
        const int nig = WGM * nN, gid = wgid / nig, fm = gid * WGM, gsz = (nM - fm) < WGM ? (nM - fm) : WGM;
        u.pm = fm + ((wgid % nig) % gsz); u.pn = (wgid % nig) / gsz; u.ko = 0; return true;
    }
    __device__ __forceinline__ void a_ready(const Unit&) const {}
    __device__ __forceinline__ void done(const Unit&) const {}
};

__device__ __forceinline__ unsigned cvt_pk_bf16(float lo, float hi) { unsigned r; asm volatile("v_cvt_pk_bf16_f32 %0, %1, %2" : "=v"(r) : "v"(lo), "v"(hi)); return r; }
template <class Epi, class Sched, bool ALIGN_EPI = false, bool SP2 = false>
__device__ __forceinline__ void gemm_phase(PG8_LAS unsigned char* lds, const Gemm g, const Sched& S, const Epi& E) {
    int tid_ = threadIdx.x; asm volatile("" : "+v"(tid_)); const int tid = tid_, wid = __builtin_amdgcn_readfirstlane(tid >> 6), lane = tid & 63, wr = wid >> 2, wc = wid & 3, fr = lane & 15, fq = lane >> 4;
    const int K = g.K, nt = K / BK;
    unsigned voffA[2], voffB[2];
#pragma unroll
    for (int i = 0; i < 2; ++i) { int R, C; stage_rc(tid * 16 + i * 8192, R, C); const int Rb = Epi::PERM ? ((R & ~31) + perm32(R & 31)) : R;
        voffA[i] = (unsigned)(R * g.lda + C) * 2u; voffB[i] = (unsigned)(Rb * g.ldb + C) * 2u; }
    const size_t kstep = (size_t)(BK * 2);
    const size_t hstepA = (size_t)HALF * g.lda * 2, hstepB = (size_t)HALF * g.ldb * 2;
    const size_t tstepA = 2 * hstepA, tstepB = 2 * hstepB;
    const unsigned ldsw = (unsigned)wid * 1024u;
    const int aoff = lds_byte(wr * 64 + fr, fq * 8), boff = lds_byte(wc * 32 + fr, fq * 8);
#define PG8_SA(b, h) (((b) * 2 + (h)) * HTB)
#define PG8_SB(b, h) ((4 + (b) * 2 + (h)) * HTB)
#define PG8_STAGE(bufoff, gbase, voff) do { _Pragma("unroll") for (int _i = 0; _i < 2; ++_i) \
        __builtin_amdgcn_global_load_lds((const unsigned*)((const char*)(gbase) + (voff)[_i]), (PG8_LAS unsigned*)(lds + (bufoff) + ldsw + _i * 8192), 16, 0, 0); } while (0)
#define PG8_LDA(dst, b, h) do { _Pragma("unroll") for (int m = 0; m < 4; ++m) _Pragma("unroll") for (int k = 0; k < 2; ++k) dst[m][k] = *(const PG8_LAS bf16x8*)(lds + PG8_SA(b, h) + aoff + m * 2048 + k * 1024); } while (0)
#define PG8_LDB(dst, b, h) do { _Pragma("unroll") for (int n = 0; n < 2; ++n) _Pragma("unroll") for (int k = 0; k < 2; ++k) dst[n][k] = *(const PG8_LAS bf16x8*)(lds + PG8_SB(b, h) + boff + n * 2048 + k * 1024); } while (0)
#define PG8_MMA(ai, bj, At, Bt) do { __builtin_amdgcn_s_setprio(1); _Pragma("unroll") for (int m = 0; m < 4; ++m) _Pragma("unroll") for (int n = 0; n < 2; ++n) _Pragma("unroll") for (int k = 0; k < 2; ++k) \
        acc[ai][bj][m][n] = __builtin_amdgcn_mfma_f32_16x16x32_bf16(Bt[n][k], At[m][k], acc[ai][bj][m][n], 0, 0, 0); __builtin_amdgcn_s_setprio(0); } while (0)
#define PG8_WAIT_V(n) asm volatile("s_waitcnt vmcnt(" #n ")" ::: "memory")
#define PG8_WAIT_L(n) asm volatile("s_waitcnt lgkmcnt(" #n ")" ::: "memory")
#define PG8_BAR __builtin_amdgcn_s_barrier()
#define PG8_SCHED __builtin_amdgcn_sched_barrier(0)
    Unit cur, nxt; int ui = 0;
    if (!S.next(0, cur)) return;
    f32x4 acc[2][2][4][2];
#pragma unroll
    for (int a = 0; a < 2; ++a)
#pragma unroll
        for (int b = 0; b < 2; ++b)
#pragma unroll
            for (int m = 0; m < 4; ++m)
#pragma unroll
                for (int n = 0; n < 2; ++n) acc[a][b][m][n] = (f32x4){0.f, 0.f, 0.f, 0.f};
    bf16x8 At[4][2], B0[2][2], B1[2][2];
    const char* cA = (const char*)g.A + (size_t)(g.amap ? cur.pm + (cur.pm >> 4) : cur.pm) * tstepA + (size_t)cur.ko * 2; const char* cB = (const char*)g.Bt + (size_t)cur.pn * tstepB + (size_t)cur.ko * 2;
    S.a_ready(cur);
    if constexpr (SP2) {
        PG8_STAGE(PG8_SB(0, 0), cB, voffB); PG8_STAGE(PG8_SB(0, 1), cB + hstepB, voffB); PG8_STAGE(PG8_SA(0, 0), cA, voffA); PG8_STAGE(PG8_SA(0, 1), cA + hstepA, voffA);
        if (wr == 1) PG8_BAR;
        PG8_WAIT_V(2); PG8_BAR;
        PG8_STAGE(PG8_SB(1, 0), cB + kstep, voffB); PG8_STAGE(PG8_SA(1, 0), cA + kstep, voffA); PG8_STAGE(PG8_SB(1, 1), cB + hstepB + kstep, voffB);
        PG8_WAIT_V(6); PG8_BAR;
    } else {
        PG8_STAGE(PG8_SB(0, 0), cB, voffB); PG8_STAGE(PG8_SA(0, 0), cA, voffA); PG8_STAGE(PG8_SB(0, 1), cB + hstepB, voffB); PG8_STAGE(PG8_SA(0, 1), cA + hstepA, voffA);
        if (wr == 1) PG8_BAR;
        PG8_WAIT_V(4); PG8_BAR;
        PG8_STAGE(PG8_SB(1, 0), cB + kstep, voffB); PG8_STAGE(PG8_SA(1, 0), cA + kstep, voffA); PG8_STAGE(PG8_SB(1, 1), cB + hstepB + kstep, voffB);
        PG8_WAIT_V(6); PG8_BAR;
    }
    for (;;) {
        const bool has_next = S.next(ui + 1, nxt);
        const char* nA = has_next ? (const char*)g.A + (size_t)(g.amap ? nxt.pm + (nxt.pm >> 4) : nxt.pm) * tstepA + (size_t)nxt.ko * 2 : cA; const char* nB = has_next ? (const char*)g.Bt + (size_t)nxt.pn * tstepB + (size_t)nxt.ko * 2 : cB;
        for (int t = 0; t < nt; t += 2) {
            const bool last = (t == nt - 2);
            const char* a1 = cA + (size_t)(t + 1) * kstep;
            const char* a2 = last ? nA : cA + (size_t)(t + 2) * kstep; const char* b2 = last ? nB : cB + (size_t)(t + 2) * kstep;
            const char* a3 = a2 + kstep; const char* b3 = b2 + kstep;
            if (last && has_next) S.a_ready(nxt);
            if constexpr (SP2) {
            PG8_LDB(B0, 0, 0); PG8_LDB(B1, 0, 1); PG8_SCHED; PG8_LDA(At, 0, 0); PG8_STAGE(PG8_SA(1, 1), a1 + hstepA, voffA);
            PG8_WAIT_V(8); PG8_WAIT_L(0); PG8_BAR; PG8_MMA(0, 0, At, B0); PG8_MMA(0, 1, At, B1); PG8_BAR; PG8_SCHED;
            PG8_LDA(At, 0, 1); PG8_STAGE(PG8_SB(0, 0), b2, voffB); PG8_STAGE(PG8_SB(0, 1), b2 + hstepB, voffB); PG8_STAGE(PG8_SA(0, 0), a2, voffA);
            PG8_WAIT_V(8); PG8_WAIT_L(0); PG8_BAR; PG8_MMA(1, 0, At, B0); PG8_MMA(1, 1, At, B1); PG8_BAR; PG8_SCHED;
            PG8_LDB(B0, 1, 0); PG8_LDB(B1, 1, 1); PG8_SCHED; PG8_LDA(At, 1, 0); PG8_STAGE(PG8_SA(0, 1), a2 + hstepA, voffA);
            PG8_WAIT_V(8); PG8_WAIT_L(0); PG8_BAR; PG8_MMA(0, 0, At, B0); PG8_MMA(0, 1, At, B1); PG8_BAR; PG8_SCHED;
            PG8_LDA(At, 1, 1); PG8_STAGE(PG8_SB(1, 0), b3, voffB); PG8_STAGE(PG8_SB(1, 1), b3 + hstepB, voffB); PG8_STAGE(PG8_SA(1, 0), a3, voffA);
            PG8_WAIT_V(8); PG8_WAIT_L(0); PG8_BAR; PG8_MMA(1, 0, At, B0); PG8_MMA(1, 1, At, B1); PG8_BAR; PG8_SCHED;
            } else {
            PG8_LDB(B0, 0, 0); PG8_SCHED; PG8_LDA(At, 0, 0); PG8_STAGE(PG8_SA(1, 1), a1 + hstepA, voffA);
            PG8_WAIT_L(8); PG8_BAR; PG8_WAIT_L(0); PG8_MMA(0, 0, At, B0); PG8_BAR; PG8_SCHED;
            PG8_LDB(B1, 0, 1); PG8_STAGE(PG8_SB(0, 0), b2, voffB);
            PG8_BAR; PG8_WAIT_L(0); PG8_MMA(0, 1, At, B1); PG8_BAR;
            PG8_LDA(At, 0, 1); PG8_STAGE(PG8_SA(0, 0), a2, voffA);
            PG8_BAR; PG8_WAIT_L(0); PG8_MMA(1, 0, At, B0); PG8_BAR; PG8_SCHED;
            PG8_STAGE(PG8_SB(0, 1), b2 + hstepB, voffB);
            PG8_WAIT_V(6); PG8_BAR; PG8_MMA(1, 1, At, B1); PG8_BAR;
            PG8_LDB(B0, 1, 0); PG8_SCHED; PG8_LDA(At, 1, 0); PG8_STAGE(PG8_SA(0, 1), a2 + hstepA, voffA);
            PG8_WAIT_L(8); PG8_BAR; PG8_WAIT_L(0); PG8_MMA(0, 0, At, B0); PG8_BAR; PG8_SCHED;
            PG8_LDB(B1, 1, 1); PG8_STAGE(PG8_SB(1, 0), b3, voffB);
            PG8_BAR; PG8_WAIT_L(0); PG8_MMA(0, 1, At, B1); PG8_BAR;
            PG8_LDA(At, 1, 1); PG8_STAGE(PG8_SA(1, 0), a3, voffA);
            PG8_BAR; PG8_WAIT_L(0); PG8_MMA(1, 0, At, B0); PG8_BAR; PG8_SCHED;
            PG8_STAGE(PG8_SB(1, 1), b3 + hstepB, voffB);
            PG8_WAIT_V(6); PG8_BAR; PG8_MMA(1, 1, At, B1); PG8_BAR;
            }
        }
        if constexpr (ALIGN_EPI) { if (wr == 0) PG8_BAR; }
        if constexpr (!Epi::AFTER_DRAIN) { E(acc, cur, wr, wc, fr, fq); S.done(cur); }
        if (!has_next) break;
#pragma unroll
        for (int a = 0; a < 2; ++a)
#pragma unroll
            for (int b = 0; b < 2; ++b)
#pragma unroll
                for (int m = 0; m < 4; ++m)
#pragma unroll
                    for (int n = 0; n < 2; ++n) acc[a][b][m][n] = (f32x4){0.f, 0.f, 0.f, 0.f};
        cur = nxt; cA = nA; cB = nB; ++ui;
        if constexpr (ALIGN_EPI) { if (wr == 1) PG8_BAR; }
    }
    PG8_WAIT_V(0);
    if constexpr (!ALIGN_EPI) { if (wr == 0) PG8_BAR; }
    PG8_BAR;
    if constexpr (Epi::AFTER_DRAIN) { E.fused(acc, cur, wr, wc, fr, fq, lds, wid, lane); S.done(cur); }
#undef PG8_SA
#undef PG8_SB
#undef PG8_STAGE
#undef PG8_LDA
#undef PG8_LDB
#undef PG8_MMA
#undef PG8_WAIT_V
#undef PG8_WAIT_L
#undef PG8_BAR
#undef PG8_SCHED
}
}
#include <hip/hip_bf16.h>
#include <cmath>
namespace attn_body {
using bf16=__hip_bfloat16;
using bf16x8=__attribute__((ext_vector_type(8)))short;
using s16x4=__attribute__((ext_vector_type(4)))short;
using f32x16=__attribute__((ext_vector_type(16)))float;
using u32x4=__attribute__((ext_vector_type(4)))unsigned;
constexpr int D=64,DM=2816;
constexpr int NW=8,QBLK=32,QB=QBLK*NW,KVBLK=64;
constexpr int ATTN_PITCH=DM, ATTN_UNIT_ROWS=QB;
__device__ __forceinline__ int crow(int r,int hi){return (r&3)+8*(r>>2)+4*hi;}
#define SBAR() __builtin_amdgcn_sched_barrier(0)
__device__ __forceinline__ void cmask(f32x16&p0,f32x16&p1,int jb,int qrel,int hi){
  const float NEG=-INFINITY; int kb=64*jb+4*hi;
  #pragma unroll
  for(int r=0;r<16;++r){int kv=kb+(r&3)+8*(r>>2); if(kv>qrel)p0[r]=NEG; if(kv+32>qrel)p1[r]=NEG;}
}

constexpr int NSLOT=3, SLOTB=8192;
constexpr int LDS_K=0, LDS_V=NSLOT*SLOTB, LDS_WS=2*NSLOT*SLOTB, LDS_OST=LDS_WS+NW*64*4, LDS_BYTES=LDS_OST+NW*4096;
constexpr float C2=0.125f*1.4426950408889634f;
__device__ __forceinline__ void glds16(const void*gsrc,unsigned lds_dst){unsigned keep;
  asm volatile("s_mov_b32 %0, m0\n\ts_mov_b32 m0, %2\n\ts_nop 0\n\tglobal_load_lds_dwordx4 %1, off\n\ts_mov_b32 m0, %0":"=&s"(keep):"v"(gsrc),"s"(lds_dst):"memory");}
__device__ __forceinline__ float max3f(float a,float b,float c){float r;asm("v_max3_f32 %0, %1, %2, %3":"=v"(r):"v"(a),"v"(b),"v"(c));return r;}
__device__ __forceinline__ float max2f(float a,float b){float r;asm("v_max_f32_e32 %0, %1, %2":"=v"(r):"v"(a),"v"(b));return r;}
__device__ __forceinline__ float fadd_s(float a,float b){float r;asm("v_add_f32_e32 %0, %1, %2":"=v"(r):"v"(a),"v"(b));return r;}
__device__ __forceinline__ float fsub_s(float a,float b){float r;asm("v_sub_f32_e32 %0, %1, %2":"=v"(r):"v"(a),"v"(b));return r;}
typedef float f32x2_t __attribute__((ext_vector_type(2))); typedef __bf16 bf16x2_t __attribute__((ext_vector_type(2)));
__device__ __forceinline__ unsigned cvtpk_s(float lo,float hi){f32x2_t v={lo,hi};bf16x2_t b=__builtin_convertvector(v,bf16x2_t);return __builtin_bit_cast(unsigned,b);}
#define WAIT_BAR(N) asm volatile("s_waitcnt vmcnt(" #N ") lgkmcnt(0)\n\ts_barrier":::"memory")

__device__ __forceinline__ void qkt(f32x16&p0,f32x16&p1,const char*Kslot,const bf16x8*qr,const f32x16&negm,int r32,int hi){
  const char*kb=Kslot+hi*1024+r32*16;
  #pragma unroll
  for(int d0=0;d0<4;++d0){
    const bf16x8 b0=*reinterpret_cast<const bf16x8*>(kb+d0*2048);
    const bf16x8 b1=*reinterpret_cast<const bf16x8*>(kb+d0*2048+512);
    if(d0==0){p0=__builtin_amdgcn_mfma_f32_32x32x16_bf16(b0,qr[0],negm,0,0,0);p1=__builtin_amdgcn_mfma_f32_32x32x16_bf16(b1,qr[0],negm,0,0,0);}
    else{p0=__builtin_amdgcn_mfma_f32_32x32x16_bf16(b0,qr[d0],p0,0,0,0);p1=__builtin_amdgcn_mfma_f32_32x32x16_bf16(b1,qr[d0],p1,0,0,0);}}
}
typedef __attribute__((address_space(3))) const char* lds_cptr;
typedef short v4i16_t __attribute__((ext_vector_type(4)));
__device__ __forceinline__ void kload8(bf16x8*kf,lds_cptr kp){
  kf[0]=*(const __attribute__((address_space(3))) bf16x8*)(kp);      kf[1]=*(const __attribute__((address_space(3))) bf16x8*)(kp+512);
  kf[2]=*(const __attribute__((address_space(3))) bf16x8*)(kp+2048); kf[3]=*(const __attribute__((address_space(3))) bf16x8*)(kp+2560);
  kf[4]=*(const __attribute__((address_space(3))) bf16x8*)(kp+4096); kf[5]=*(const __attribute__((address_space(3))) bf16x8*)(kp+4608);
  kf[6]=*(const __attribute__((address_space(3))) bf16x8*)(kp+6144); kf[7]=*(const __attribute__((address_space(3))) bf16x8*)(kp+6656);
}
__device__ __forceinline__ void kload2(bf16x8*kf,lds_cptr kp,int j){ kf[2*j]=*(const __attribute__((address_space(3))) bf16x8*)(kp+j*2048); kf[2*j+1]=*(const __attribute__((address_space(3))) bf16x8*)(kp+j*2048+512); }
__device__ __forceinline__ s16x4 vtr(lds_cptr p){ return __builtin_bit_cast(s16x4,__builtin_amdgcn_ds_read_tr16_b64_v4i16((__attribute__((address_space(3))) v4i16_t*)p)); }
__device__ __forceinline__ float rowmax(const f32x16&p0,const f32x16&p1){
  float a=max3f(p0[0],p0[1],p1[0]),b=max3f(p0[2],p0[3],p1[1]);a=max3f(a,p1[2],p1[3]);
  #pragma unroll
  for(int r=4;r<16;r+=4){a=max3f(a,p0[r],p0[r+1]);b=max3f(b,p0[r+2],p0[r+3]);a=max3f(a,p1[r],p1[r+1]);b=max3f(b,p1[r+2],p1[r+3]);}
  const float m=max2f(a,b);
  auto rr=__builtin_amdgcn_permlane32_swap(__float_as_uint(m),__float_as_uint(m),false,false);
  return max2f(__uint_as_float(rr[0]),__uint_as_float(rr[1]));
}
__device__ __forceinline__ void pv(f32x16*o,int vb,bf16x8 pa0,bf16x8 pa1,bf16x8 pa2,bf16x8 pa3){
  #pragma unroll
  for(int d0=0;d0<2;++d0){s16x4 lo[4],hi[4];
    #pragma unroll
    for(int ks=0;ks<4;++ks){
      asm volatile("ds_read_b64_tr_b16 %0,%1 offset:%c2":"=&v"(lo[ks]):"v"(vb),"i"(d0*4096+ks*1024):"memory");
      asm volatile("ds_read_b64_tr_b16 %0,%1 offset:%c2":"=&v"(hi[ks]):"v"(vb),"i"(d0*4096+ks*1024+512):"memory");}
    asm volatile("s_waitcnt lgkmcnt(0)":::"memory");SBAR();
    #define PK(k) (bf16x8){lo[k][0],lo[k][1],lo[k][2],lo[k][3],hi[k][0],hi[k][1],hi[k][2],hi[k][3]}
    o[d0]=__builtin_amdgcn_mfma_f32_32x32x16_bf16(pa0,PK(0),o[d0],0,0,0);
    o[d0]=__builtin_amdgcn_mfma_f32_32x32x16_bf16(pa1,PK(1),o[d0],0,0,0);
    o[d0]=__builtin_amdgcn_mfma_f32_32x32x16_bf16(pa2,PK(2),o[d0],0,0,0);
    o[d0]=__builtin_amdgcn_mfma_f32_32x32x16_bf16(pa3,PK(3),o[d0],0,0,0);
    #undef PK
  }
}

#ifndef ATTN_STORE16
#define ATTN_STORE16(p,v) (*(u32x4*)(p)=(v))
#endif
template<int THRL> __device__ __forceinline__ void attn_unit(const bf16*Qb,const bf16*Kh,const bf16*Vh,bf16*Ob,const int NT,char*shm){
  int tid_=threadIdx.x; asm volatile("":"+v"(tid_)); const int tid=tid_,lane=tid&63,r32=lane&31,hi=lane>>5; const int wid=__builtin_amdgcn_readfirstlane(tid>>6);
  const bf16*Qw=Qb+(long)(wid*QBLK)*DM;
  const unsigned lds0=(unsigned)(uintptr_t)shm;
  float*wsf=(float*)(shm+LDS_WS)+wid*64;
  const bf16*ksrc=Kh+(long)lane*DM+wid*8;
  const bf16*vsrc=Vh+(long)(16*(wid&3)+(lane>>2))*DM+(wid>>2)*32+(lane&3)*8;
  const unsigned kdst=lds0+LDS_K+wid*1024, vdst=lds0+LDS_V+wid*1024;
  #define DMA_K(t,slot) glds16(ksrc+(long)(t)*KVBLK*DM,(unsigned)__builtin_amdgcn_readfirstlane(kdst+(slot)))
  #define DMA_V(t,slot) glds16(vsrc+(long)(t)*KVBLK*DM,(unsigned)__builtin_amdgcn_readfirstlane(vdst+(slot)))
  const int vb0=(int)(lds0+LDS_V)+((lane>>4)&1)*32+(lane&3)*8+(4*hi+((lane&15)>>2))*64;
  const char*Kbase=shm+LDS_K; bf16x8 kf[8];
  const lds_cptr shm3=(lds_cptr)shm; const lds_cptr kp0=shm3+LDS_K+hi*1024+r32*16; const lds_cptr vp0=shm3+LDS_V+((lane>>4)&1)*32+(lane&3)*8+(4*hi+((lane&15)>>2))*64;
  DMA_K(0,0);DMA_V(0,0);DMA_K(1,SLOTB);
  bf16x8 qr[4];
  #pragma unroll
  for(int d0=0;d0<4;++d0)qr[d0]=*reinterpret_cast<const bf16x8*>(&Qw[(long)r32*DM+d0*16+hi*8]);
  float mhat=0.f,l_reg=0.f;f32x16 o[2];o[0]=f32x16{};o[1]=f32x16{};f32x16 negm=f32x16{};asm volatile("":"+v"(negm));
  #define CMASK(P0,P1,t) do{}while(0)
  bool resc=false;
  #define START(P0,P1) do{ const float rm=rowmax(P0,P1); resc=false; \
    { const float dl=rm; mhat=fadd_s(mhat,dl); \
      _Pragma("unroll") for(int r=0;r<16;++r){P0[r]=fsub_s(P0[r],dl);P1[r]=fsub_s(P1[r],dl);} \
      _Pragma("unroll") for(int r=0;r<16;++r)negm[r]=-mhat; asm volatile("":"+v"(negm)); } \
    _Pragma("unroll") for(int r=0;r<16;++r)P0[r]=__builtin_amdgcn_exp2f(P0[r]); }while(0)
  #define RESC() do{ if(resc){ asm volatile("s_waitcnt lgkmcnt(0)":::"memory"); \
      _Pragma("unroll") for(int d_=0;d_<2;++d_) _Pragma("unroll") for(int r=0;r<16;++r)o[d_][r]*=wsf[crow(r,hi)]; } }while(0)
  f32x16 pA0,pA1,pB0,pB1;
  int sl_prev=0,sl_cur=0,sl_next=SLOTB;
  #define ROT() do{sl_prev=sl_cur;sl_cur=sl_next;sl_next=(sl_next==(NSLOT-1)*SLOTB)?0:sl_next+SLOTB;}while(0)
  DMA_K(2,2*SLOTB);
  WAIT_BAR(3);
  qkt(pA0,pA1,Kbase,qr,negm,r32,hi);asm volatile("s_nop 15\n\ts_nop 7":"+v"(pA0),"+v"(pA1));CMASK(pA0,pA1,0);
  START(pA0,pA1);
  _Pragma("unroll") for(int r=0;r<16;++r)pA1[r]=__builtin_amdgcn_exp2f(pA1[r]);
  WAIT_BAR(0);
  DMA_K(3,0);DMA_V(1,SLOTB);
  ROT();
  kload8(kf,kp0+sl_cur);
  WAIT_BAR(2);
  s16x4 vlo[8],vhi[8]; u32x4 pw0,pw1,pw2,pw3;
  #define PKW(P,B) cvtpk_s(P[B],P[B+1])
  #define PAF(k) __builtin_bit_cast(bf16x8,pw##k)
  #define VFR(i) (bf16x8){vlo[i][0],vlo[i][1],vlo[i][2],vlo[i][3],vhi[i][0],vhi[i][1],vhi[i][2],vhi[i][3]}
  #define PIN(x) asm volatile("":"+v"(x))
  #define MX3(a,b,c) __builtin_fmaxf(__builtin_fmaxf((a),(b)),(c))
  #define GAPA(MF,A0,A1,A2,A3,W0,W1,PW) do{ MF; sacc+=A0; sacc+=A1; sacc+=A2; sacc+=A3; PIN(sacc); W0; W1; PIN(PW); SBAR(); }while(0)
  #define EX(v) __builtin_amdgcn_exp2f(v)
  #define GAPB(MF,X,B) do{ MF; X[B]=EX(X[B]); X[B+1]=EX(X[B+1]); X[B+2]=EX(X[B+2]); X[B+3]=EX(X[B+3]); PIN(X); SBAR(); }while(0)
  #define VRD(i) do{ vlo[i]=vtr(vp_+(((i)>>2)*4096+((i)&3)*1024)); vhi[i]=vtr(vp_+(((i)>>2)*4096+((i)&3)*1024+512)); }while(0)
  #define KRD(G,j) do{ if(G){ kload2(kf,kp0+sl_next,j); SBAR(); } }while(0)
  #define STEP(C0,C1,P0,P1,t,GK,GV,GL) do{ SBAR(); \
    const lds_cptr vp_=vp0+sl_prev; \
    VRD(0); SBAR(); float sacc=(P0[0]+P0[1]); \
    GAPA(C0=__builtin_amdgcn_mfma_f32_32x32x16_bf16(kf[0],qr[0],negm,0,0,0), P0[2],P0[3],P0[4],P0[5],     pw0[0]=PKW(P0,0), pw0[1]=PKW(P0,2), pw0); \
    VRD(4); SBAR(); GAPA(C1=__builtin_amdgcn_mfma_f32_32x32x16_bf16(kf[1],qr[0],negm,0,0,0), P0[6],P0[7],P0[8],P0[9],     pw0[2]=PKW(P0,4), pw0[3]=PKW(P0,6), pw0); \
    VRD(1); SBAR(); GAPA(C0=__builtin_amdgcn_mfma_f32_32x32x16_bf16(kf[2],qr[1],C0,0,0,0),   P0[10],P0[11],P0[12],P0[13], pw1[0]=PKW(P0,8), pw1[1]=PKW(P0,10), pw1); \
    VRD(5); SBAR(); GAPA(C1=__builtin_amdgcn_mfma_f32_32x32x16_bf16(kf[3],qr[1],C1,0,0,0),   P0[14],P0[15],P1[0],P1[1],   pw1[2]=PKW(P0,12),pw1[3]=PKW(P0,14), pw1); \
    VRD(2); SBAR(); GAPA(C0=__builtin_amdgcn_mfma_f32_32x32x16_bf16(kf[4],qr[2],C0,0,0,0),   P1[2],P1[3],P1[4],P1[5],     pw2[0]=PKW(P1,0), pw2[1]=PKW(P1,2), pw2); \
    VRD(6); SBAR(); GAPA(C1=__builtin_amdgcn_mfma_f32_32x32x16_bf16(kf[5],qr[2],C1,0,0,0),   P1[6],P1[7],P1[8],P1[9],     pw2[2]=PKW(P1,4), pw2[3]=PKW(P1,6), pw2); \
    VRD(3); SBAR(); GAPA(C0=__builtin_amdgcn_mfma_f32_32x32x16_bf16(kf[6],qr[3],C0,0,0,0),   P1[10],P1[11],P1[12],P1[13], pw3[0]=PKW(P1,8), pw3[1]=PKW(P1,10), pw3); \
    VRD(7); SBAR(); GAPA(C1=__builtin_amdgcn_mfma_f32_32x32x16_bf16(kf[7],qr[3],C1,0,0,0),   P1[14],P1[15],0.f,0.f,       pw3[2]=PKW(P1,12),pw3[3]=PKW(P1,14), pw3); \
    l_reg+=sacc; \
    if(GK){DMA_K((t)+3,sl_cur);} if(GV){DMA_V((t)+1,sl_next);} \
    CMASK(C0,C1,t); \
    { float a=MX3(C0[0],C0[1],C1[0]),b=MX3(C0[2],C0[3],C1[1]); a=MX3(a,C1[2],C1[3]); \
      _Pragma("unroll") for(int r=4;r<16;r+=4){a=MX3(a,C0[r],C0[r+1]);b=MX3(b,C0[r+2],C0[r+3]);a=MX3(a,C1[r],C1[r+1]);b=MX3(b,C1[r+2],C1[r+3]);} \
      float rm=__builtin_fmaxf(a,b); { auto rr=__builtin_amdgcn_permlane32_swap(__float_as_uint(rm),__float_as_uint(rm),false,false); rm=__builtin_fmaxf(__uint_as_float(rr[0]),__uint_as_float(rr[1])); } \
      resc=false; \
      if(__builtin_expect(__any(rm>(float)THRL),0)){ const float dl=__builtin_fmaxf(rm,0.f); mhat+=dl; \
        _Pragma("unroll") for(int r=0;r<16;++r){C0[r]-=dl;C1[r]-=dl;} \
        _Pragma("unroll") for(int r=0;r<16;++r)negm[r]=-mhat; asm volatile("":"+v"(negm)); \
        const float f=__builtin_amdgcn_exp2f(-dl); l_reg*=f; if(hi==0)wsf[r32]=f; resc=true; } } \
    SBAR(); \
    GAPB(o[0]=__builtin_amdgcn_mfma_f32_32x32x16_bf16(PAF(0),VFR(0),o[0],0,0,0), C0,0); \
    GAPB(o[1]=__builtin_amdgcn_mfma_f32_32x32x16_bf16(PAF(0),VFR(4),o[1],0,0,0), C0,4); \
    KRD(GL,0); GAPB(o[0]=__builtin_amdgcn_mfma_f32_32x32x16_bf16(PAF(1),VFR(1),o[0],0,0,0), C0,8); \
    KRD(GL,1); GAPB(o[1]=__builtin_amdgcn_mfma_f32_32x32x16_bf16(PAF(1),VFR(5),o[1],0,0,0), C0,12); \
    KRD(GL,2); GAPB(o[0]=__builtin_amdgcn_mfma_f32_32x32x16_bf16(PAF(2),VFR(2),o[0],0,0,0), C1,0); \
    KRD(GL,3); GAPB(o[1]=__builtin_amdgcn_mfma_f32_32x32x16_bf16(PAF(2),VFR(6),o[1],0,0,0), C1,4); \
    GAPB(o[0]=__builtin_amdgcn_mfma_f32_32x32x16_bf16(PAF(3),VFR(3),o[0],0,0,0), C1,8); \
    GAPB(o[1]=__builtin_amdgcn_mfma_f32_32x32x16_bf16(PAF(3),VFR(7),o[1],0,0,0), C1,12); \
    }while(0)
  int t=1;
  #undef CMASK
  #define CMASK(P0,P1,t) do{}while(0)
  for(;t+5<NT;t+=2){
    STEP(pB0,pB1,pA0,pA1,t,true,true,true);     WAIT_BAR(2); RESC(); ROT();
    STEP(pA0,pA1,pB0,pB1,t+1,true,true,true);   WAIT_BAR(2); RESC(); ROT();
  }
  #undef CMASK
  #define CMASK(P0,P1,t) do{}while(0)
  #define ENDW(tt) do{ if((tt)+3<NT){WAIT_BAR(2);} else if((tt)+2<NT){WAIT_BAR(1);} else {WAIT_BAR(0);} }while(0)
  for(;t+1<NT;t+=2){
    STEP(pB0,pB1,pA0,pA1,t,(t+3<NT),(t+1<NT),(t+1<NT));       ENDW(t);   RESC(); ROT();
    STEP(pA0,pA1,pB0,pB1,t+1,(t+4<NT),(t+2<NT),(t+2<NT));     ENDW(t+1); RESC(); ROT();
  }
  STEP(pB0,pB1,pA0,pA1,NT-1,false,false,false); RESC();
  { float sacc=pB0[0]+pB0[1]; _Pragma("unroll") for(int r=2;r<16;++r)sacc+=pB0[r]; _Pragma("unroll") for(int r=0;r<16;++r)sacc+=pB1[r]; l_reg+=sacc;
    pw0=(u32x4){PKW(pB0,0),PKW(pB0,2),PKW(pB0,4),PKW(pB0,6)};pw1=(u32x4){PKW(pB0,8),PKW(pB0,10),PKW(pB0,12),PKW(pB0,14)};pw2=(u32x4){PKW(pB1,0),PKW(pB1,2),PKW(pB1,4),PKW(pB1,6)};pw3=(u32x4){PKW(pB1,8),PKW(pB1,10),PKW(pB1,12),PKW(pB1,14)};
    SBAR(); pv(o,vb0+sl_cur,PAF(0),PAF(1),PAF(2),PAF(3)); }
  #undef PKW
  #undef PAF
  #undef VFR
  #undef PIN
  #undef MX3
  #undef GAPA
  #undef GAPB
  #undef EX
  #undef VRD
  #undef KRD
  #undef STEP
  #undef ENDW
  {auto rr=__builtin_amdgcn_permlane32_swap(__float_as_uint(l_reg),__float_as_uint(l_reg),false,false);l_reg=__uint_as_float(rr[0])+__uint_as_float(rr[1]);}
  if(hi==0)wsf[32+r32]=l_reg;asm volatile("s_waitcnt lgkmcnt(0)":::"memory");
  float rli[16];
  #pragma unroll
  for(int r=0;r<16;++r)rli[r]=__builtin_amdgcn_rcpf(wsf[32+crow(r,hi)]);
  bf16*Ow=Ob+(long)(wid*QBLK)*DM;
  { bf16*stg=(bf16*)(shm+LDS_OST)+wid*2048;
    #pragma unroll
    for(int r=0;r<16;++r){const int orow=crow(r,hi);
      #pragma unroll
      for(int d0=0;d0<2;++d0)stg[orow*64+d0*32+r32]=__float2bfloat16(o[d0][r]*rli[r]);}
    asm volatile("s_waitcnt lgkmcnt(0)":::"memory");
    #pragma unroll
    for(int i=0;i<4;++i){const int row=i*8+(lane>>3),ch=lane&7; const u32x4 v=*(const u32x4*)(stg+row*64+ch*8); ATTN_STORE16(Ow+(long)row*DM+ch*8,v);} }
  asm volatile("s_waitcnt lgkmcnt(0)\n\ts_barrier":::"memory");
  #undef DMA_K
  #undef DMA_V
  #undef CMASK
  #undef START
  #undef RESC
  #undef ROT
}
constexpr int ATTN_LDS_BYTES=LDS_BYTES;
#undef SBAR
#undef WAIT_BAR
}
typedef unsigned short bf16_t;
typedef float f32x4 __attribute__((ext_vector_type(4)));
typedef unsigned u32x4 __attribute__((ext_vector_type(4)));
typedef unsigned u32x2 __attribute__((ext_vector_type(2)));
typedef short bf16x8 __attribute__((ext_vector_type(8)));

constexpr int NB = 4, SEQL = 4096, CTXL = 256, ROWB = SEQL + CTXL, NROW = NB * ROWB;
constexpr int DM = 1024, PP = 2816, DFF = 4096, NLAYER = 2, INC = 2712, MODW = 6144;
constexpr int NTHR = 512, NWV = 8;
constexpr float LN_EPS = 1e-6f;
constexpr float DN_ALPHA = 1.41421356237309515f;
constexpr int PC_U = 0, PC_AQ = 256, PC_Z = 640, PC_GV = 1024, PC_AK = 1280, PC_AV = 1408, PC_DQ = 1536, PC_DK = 1920, PC_DV = 2304, PC_AB = 2688;
constexpr size_t MiB = 1u << 20;
constexpr size_t WS_P = 0;
constexpr size_t WS_DNSH = 94 * MiB;
constexpr size_t WS_DNPD = WS_DNSH + (size_t)1632 * 16384;
constexpr size_t WS_DNVEC = WS_DNPD + (size_t)3264 * 24576;
constexpr size_t WS_DNEND = WS_DNVEC + (size_t)3264 * 768;
constexpr size_t WS_H = 0;
constexpr size_t WS_PART = 172 * MiB;
constexpr size_t WS_XN = 136 * MiB;
constexpr size_t WS_W = 200 * MiB;
constexpr size_t W_IN_OFF = 0, W_OUT_OFF = (size_t)2816 * 1024 * 2, W_UP_OFF = W_OUT_OFF + (size_t)1024 * 1024 * 2, W_DN_OFF = W_UP_OFF + (size_t)4096 * 1024 * 2, W_LAYER = W_DN_OFF + (size_t)4096 * 1024 * 2;
constexpr size_t WS_XCTX = 247 * MiB;
constexpr size_t WS_AB = 251 * MiB;
constexpr size_t WS_MODV = 253 * MiB;
static_assert(WS_DNEND <= 200 * MiB && WS_W + 2 * W_LAYER <= WS_XCTX && WS_AB + (size_t)NROW * 96 <= WS_MODV, "ws map");

__device__ __forceinline__ float bf2f(unsigned v) { return __uint_as_float(v << 16); }
typedef float f32x2_t __attribute__((ext_vector_type(2))); typedef __bf16 bf16x2_t __attribute__((ext_vector_type(2)));
__device__ __forceinline__ unsigned pk2(float lo, float hi) { f32x2_t v = {lo, hi}; return __builtin_bit_cast(unsigned, __builtin_convertvector(v, bf16x2_t)); }
__device__ __forceinline__ unsigned f2bf(float f) { return pk2(f, 0.f) & 0xffffu; }
__device__ __forceinline__ float wave_sum(float v) {
#pragma unroll
    for (int o = 1; o < 64; o <<= 1) v += __shfl_xor(v, o);
    return v;
}
__device__ __forceinline__ float gelu_f(float v) {
    const float t = __builtin_amdgcn_rcpf(fabsf(v) * 0.2316418882f + 1.0f);
    float q = t * 0.5307027145f + (-0.7265760135f); q = q * t + 0.7107068705f; q = q * t + (-0.142248368f); q = q * t + 0.127414796f; q = q * t;
    const float e = __builtin_amdgcn_exp2f((v * v) * (-0.72134752044f));
    const float m = v * (q * e);
    return v < 0.f ? m : v - m;
}
__device__ __forceinline__ float silu_f(float x) { return x / (1.0f + __expf(-x)); }
__device__ __forceinline__ void unpack8(u32x4 w, float (&f)[8]) {
    f[0] = bf2f(w.x & 0xffffu); f[1] = bf2f(w.x >> 16); f[2] = bf2f(w.y & 0xffffu); f[3] = bf2f(w.y >> 16);
    f[4] = bf2f(w.z & 0xffffu); f[5] = bf2f(w.z >> 16); f[6] = bf2f(w.w & 0xffffu); f[7] = bf2f(w.w >> 16);
}
__device__ __forceinline__ u32x4 pack8(const float (&f)[8]) { u32x4 w; w.x = pk2(f[0], f[1]); w.y = pk2(f[2], f[3]); w.z = pk2(f[4], f[5]); w.w = pk2(f[6], f[7]); return w; }

namespace pg8 {
struct EpiP {
    static constexpr bool PERM = true, AFTER_DRAIN = false;
    bf16_t* P; float* AB;
    __device__ __forceinline__ void operator()(const f32x4 (&acc)[2][2][4][2], const Unit& u, int wr, int wc, int fr, int fq) const {
        const int row0 = u.pm * BM + wr * 64 + fr, col0 = u.pn * BM + wc * 32 + 8 * fq;
#pragma unroll
        for (int ai = 0; ai < 2; ++ai)
#pragma unroll
            for (int m = 0; m < 4; ++m) { const int r = row0 + ai * HALF + m * 16;
#pragma unroll
                for (int bj = 0; bj < 2; ++bj) { const int c = col0 + bj * HALF; const f32x4 v0 = acc[ai][bj][m][0], v1 = acc[ai][bj][m][1];
                    u32x4 w; w.x = cvt_pk_bf16(v0[0], v0[1]); w.y = cvt_pk_bf16(v0[2], v0[3]); w.z = cvt_pk_bf16(v1[0], v1[1]); w.w = cvt_pk_bf16(v1[2], v1[3]);
                    *(u32x4*)(P + (size_t)r * PP + c) = w;
                    if (c >= PC_AB && c < INC) { float* ab = AB + (size_t)r * 24 + (c - PC_AB); *(f32x4*)ab = v0; *(f32x4*)(ab + 4) = v1; } } }
    }
};
struct EpiH {
    static constexpr bool PERM = true, AFTER_DRAIN = false;
    bf16_t* H;
    __device__ __forceinline__ void operator()(const f32x4 (&acc)[2][2][4][2], const Unit& u, int wr, int wc, int fr, int fq) const {
        const int row0 = u.pm * BM + wr * 64 + fr, col0 = u.pn * BM + wc * 32 + 8 * fq;
#pragma unroll
        for (int ai = 0; ai < 2; ++ai)
#pragma unroll
            for (int m = 0; m < 4; ++m) { const int r = row0 + ai * HALF + m * 16;
#pragma unroll
                for (int bj = 0; bj < 2; ++bj) { const int c = col0 + bj * HALF; f32x4 v0 = acc[ai][bj][m][0], v1 = acc[ai][bj][m][1];
#pragma unroll
                    for (int e = 0; e < 4; ++e) { const float a = fmaxf(v0[e], 0.f), b = fmaxf(v1[e], 0.f); v0[e] = a * a; v1[e] = b * b; }
                    u32x4 w; w.x = cvt_pk_bf16(v0[0], v0[1]); w.y = cvt_pk_bf16(v0[2], v0[3]); w.z = cvt_pk_bf16(v1[0], v1[1]); w.w = cvt_pk_bf16(v1[2], v1[3]);
                    *(u32x4*)(H + (size_t)r * DFF + c) = w; } }
    }
};
struct EpiRes {
    static constexpr bool PERM = false, AFTER_DRAIN = false;
    const float* srclat; const float* srcctx; float* dstlat; float* dstctx; const float* gate; int compact;
    __device__ __forceinline__ void operator()(const f32x4 (&acc)[2][2][4][2], const Unit& u, int wr, int wc, int fr, int fq) const {
        const int b = compact ? (u.pm >> 4) : u.pm / 17, tt = compact ? (u.pm & 15) : u.pm - b * 17; const bool lat = tt < 16;
        const float* sp = lat ? srclat + (size_t)(b * SEQL + tt * 256) * DM : srcctx + (size_t)(b * CTXL) * DM;
        float* dp = lat ? dstlat + (size_t)(b * SEQL + tt * 256) * DM : dstctx + (size_t)(b * CTXL) * DM;
        const float* gp = gate + (size_t)(lat ? b : 4) * MODW;
#pragma unroll
        for (int bj = 0; bj < 2; ++bj)
#pragma unroll
            for (int n = 0; n < 2; ++n) { const int col = u.pn * BM + bj * HALF + wc * 32 + n * 16 + 4 * fq; const f32x4 gv = *(const f32x4*)(gp + col);
#pragma unroll
                for (int ai = 0; ai < 2; ++ai)
#pragma unroll
                    for (int m = 0; m < 4; ++m) { const size_t off = (size_t)(ai * HALF + wr * 64 + m * 16 + fr) * DM + col;
                        const f32x4 xv = *(const f32x4*)(sp + off); *(f32x4*)(dp + off) = xv * DN_ALPHA + gv * acc[ai][bj][m][n];
                        if (m & 1) asm volatile("" ::: "memory"); } }
    }
};
struct CtxOrder {
    int KS, ksub, nunits, G, c;
    __host__ __device__ void init(int KS_, int ksub_, int G_, int c_) { KS = KS_; ksub = ksub_; nunits = 16 * KS_; G = G_; c = c_; }
    __host__ __device__ bool next(int i, Unit& u) const { const int L = i * G + c; if (L >= nunits) return false; const int ks = L % KS, r = L / KS; u.pn = r & 3; u.pm = (r >> 2) * 17 + 16; u.ko = ks * ksub; return true; }
    __device__ __forceinline__ void a_ready(const Unit&) const {}
    __device__ __forceinline__ void done(const Unit&) const {}
};
struct EpiCtxPart {
    static constexpr bool PERM = false, AFTER_DRAIN = false;
    float* part; const float* gate; int kshift;
    __device__ __forceinline__ void operator()(const f32x4 (&acc)[2][2][4][2], const Unit& u, int wr, int wc, int fr, int fq) const {
        asm volatile("" : "+v"(fr), "+v"(fq));
        float* dp = part + (size_t)(u.ko >> kshift) * (NB * CTXL * DM) + (size_t)((u.pm / 17) * CTXL) * DM;
#pragma unroll
        for (int bj = 0; bj < 2; ++bj)
#pragma unroll
            for (int n = 0; n < 2; ++n) { const int col = u.pn * BM + bj * HALF + wc * 32 + n * 16 + 4 * fq; const f32x4 gv = *(const f32x4*)(gate + col);
#pragma unroll
                for (int ai = 0; ai < 2; ++ai)
#pragma unroll
                    for (int m = 0; m < 4; ++m) *(f32x4*)(dp + (size_t)(ai * HALF + wr * 64 + m * 16 + fr) * DM + col) = gv * acc[ai][bj][m][n]; }
    }
};
}

__device__ __forceinline__ int win_src_col(int n0) {
    if (n0 < 256) return n0;
    if (n0 < 640) return 512 + (n0 - 256);
    if (n0 < 1024) return 2304 + (n0 - 640);
    if (n0 < 1280) return 256 + (n0 - 1024);
    if (n0 < 1408) return 896 + (n0 - 1280);
    if (n0 < 1536) return 1024 + (n0 - 1408);
    if (n0 < 2688) return 1152 + (n0 - 1536);
    return n0;
}
__device__ __forceinline__ void transpose_item(const float* W, int K, int Nsrc, int Npad, bf16_t* WT, float* scr, int item, int lane, bool perm) {
    const int nblk = Npad / 32, kb = item / nblk, nb = item - kb * nblk, k0 = 64 * kb, n0 = 32 * nb;
    const int sn = (perm ? win_src_col(n0) : n0) + (lane & 31);
    const bool ok = sn < Nsrc;
    float tv[32];
#pragma unroll
    for (int i = 0; i < 32; ++i) { const int kk = 2 * i + (lane >> 5); tv[i] = ok ? W[(size_t)(k0 + kk) * Nsrc + sn] : 0.f; }
#pragma unroll
    for (int i = 0; i < 32; ++i) { const int kk = 2 * i + (lane >> 5); scr[kk * 33 + (lane & 31)] = tv[i]; }
    __builtin_amdgcn_s_waitcnt(0); asm volatile("" ::: "memory");
    const int c = lane & 7;
#pragma unroll
    for (int j = 0; j < 4; ++j) { const int n = (lane >> 3) + 8 * j; const float* s = scr + (8 * c) * 33 + n;
        u32x4 o; o.x = pk2(s[0 * 33], s[1 * 33]); o.y = pk2(s[2 * 33], s[3 * 33]); o.z = pk2(s[4 * 33], s[5 * 33]); o.w = pk2(s[6 * 33], s[7 * 33]);
        *(u32x4*)(WT + (size_t)(n0 + n) * K + k0 + 8 * c) = o; }
    __builtin_amdgcn_s_waitcnt(0); asm volatile("" ::: "memory");
}

struct Args { const float* in[24]; float* out; unsigned char* ws; };

__device__ __forceinline__ void phase_prologue(const Args& a, unsigned char* lds, int tid, int lane, int wave, int G) {
    float* sc = (float*)lds;
    float* red = (float*)(lds + 20480);
    const float* c = a.in[1]; const float* cctx = a.in[3]; const float* mod_w = a.in[4]; const float* mod_b = a.in[5];
    float* modv = (float*)(a.ws + WS_MODV);
    for (int i = tid; i < 5120; i += NTHR) { const float v = i < 4096 ? c[i] : cctx[i - 4096]; sc[i] = v / (1.0f + expf(-v)); }
    __syncthreads();
    for (int it = blockIdx.x; it < 192; it += G) {
        const int l = it / 96, cb = it - l * 96, col = cb * 64 + lane, k0 = wave * 128;
        const float* W = mod_w + (size_t)l * 1024 * MODW + col;
        float acc0 = 0.f, acc1 = 0.f, acc2 = 0.f, acc3 = 0.f, acc4 = 0.f;
#pragma unroll 16
        for (int k = 0; k < 128; ++k) { const float wv = W[(size_t)(k0 + k) * MODW];
            acc0 += sc[k0 + k] * wv; acc1 += sc[1024 + k0 + k] * wv; acc2 += sc[2048 + k0 + k] * wv; acc3 += sc[3072 + k0 + k] * wv; acc4 += sc[4096 + k0 + k] * wv; }
        red[(wave * 5 + 0) * 64 + lane] = acc0; red[(wave * 5 + 1) * 64 + lane] = acc1; red[(wave * 5 + 2) * 64 + lane] = acc2; red[(wave * 5 + 3) * 64 + lane] = acc3; red[(wave * 5 + 4) * 64 + lane] = acc4;
        __syncthreads();
        if (tid < 320) { const int s = tid >> 6, ln = tid & 63; float sum = 0.f;
#pragma unroll
            for (int w = 0; w < 8; ++w) sum += red[(w * 5 + s) * 64 + ln];
            modv[(size_t)(l * 5 + s) * MODW + cb * 64 + ln] = sum + mod_b[(size_t)l * MODW + cb * 64 + ln]; }
        __syncthreads();
    }
    float* scr = (float*)(lds + 32768 + wave * 8704);
    const int gw = blockIdx.x * NWV + wave, NGW = G * NWV;
    constexpr int I_IN = 16 * 88, I_OUT = 16 * 32, I_UP = 16 * 128, I_DN = 64 * 32, I_L = I_IN + I_OUT + I_UP + I_DN;
    for (int it = gw; it < 2 * I_L; it += NGW) {
        const int l = it / I_L; int r = it - l * I_L; unsigned char* wb = a.ws + WS_W + (size_t)l * W_LAYER;
        if (r < I_IN) { transpose_item(a.in[6] + (size_t)l * 1024 * INC, 1024, INC, 2816, (bf16_t*)(wb + W_IN_OFF), scr, r, lane, true); continue; } r -= I_IN;
        if (r < I_OUT) { transpose_item(a.in[7] + (size_t)l * 1024 * 1024, 1024, 1024, 1024, (bf16_t*)(wb + W_OUT_OFF), scr, r, lane, false); continue; } r -= I_OUT;
        if (r < I_UP) { transpose_item(a.in[22] + (size_t)l * 1024 * DFF, 1024, DFF, DFF, (bf16_t*)(wb + W_UP_OFF), scr, r, lane, false); continue; } r -= I_UP;
        transpose_item(a.in[23] + (size_t)l * DFF * 1024, DFF, 1024, 1024, (bf16_t*)(wb + W_DN_OFF), scr, r, lane, false);
    }
}

template <int MODE>
__device__ __forceinline__ void ln_rows(const float* srclat, const float* srcctx, float* dstlat, float* dstctx, const float* lng, const float* lnb,
                                        const float* modsh  , bf16_t* XN, bool wantxn, bool latonly, bool ctxalpha  , const float* part  ,
                                        int lane, int wave, int G) {
    const int gw = blockIdx.x * NWV + wave, NGW = G * NWV;
    constexpr int RB = 4;
    for (int rb = gw; rb < NROW; rb += NGW * RB) {
        f32x4 v[RB][4]; size_t ro[RB]; bool lat[RB], act[RB]; int bsrc[RB];
#pragma unroll
        for (int q = 0; q < RB; ++q) { const int r = rb + q * NGW; const int b = r / ROWB, t = r - b * ROWB; lat[q] = t < SEQL; act[q] = r < NROW && !(latonly && !lat[q]); bsrc[q] = lat[q] ? b : 4;
            ro[q] = lat[q] ? (size_t)(b * SEQL + t) * DM : (size_t)(b * CTXL + t - SEQL) * DM;
            if (act[q]) { const float* src = (lat[q] ? srclat : srcctx) + ro[q];
#pragma unroll
                for (int j = 0; j < 4; ++j) v[q][j] = *(const f32x4*)(src + lane * 4 + 256 * j);
                if (MODE == 1 && part && !lat[q]) {
#pragma unroll
                    for (int k = 0; k < 4; ++k)
#pragma unroll
                        for (int j = 0; j < 4; ++j) v[q][j] += *(const f32x4*)(part + (size_t)k * (NB * CTXL * DM) + ro[q] + lane * 4 + 256 * j); } }
            else {
#pragma unroll
                for (int j = 0; j < 4; ++j) v[q][j] = (f32x4){0.f, 0.f, 0.f, 0.f}; } }
#pragma unroll
        for (int q = 0; q < RB; ++q) { if (!act[q]) continue;
            const int r = rb + q * NGW;
            if (MODE == 1) {
                float s = 0.f;
#pragma unroll
                for (int j = 0; j < 4; ++j) s += (v[q][j][0] + v[q][j][1]) + (v[q][j][2] + v[q][j][3]);
                const float mean = wave_sum(s) * (1.0f / DM); float qq = 0.f;
#pragma unroll
                for (int j = 0; j < 4; ++j) { v[q][j] = v[q][j] - mean; qq += (v[q][j][0] * v[q][j][0] + v[q][j][1] * v[q][j][1]) + (v[q][j][2] * v[q][j][2] + v[q][j][3] * v[q][j][3]); }
                const float rstd = 1.0f / sqrtf(wave_sum(qq) * (1.0f / DM) + LN_EPS);
                float* dst = (lat[q] ? dstlat : dstctx) + ro[q];
#pragma unroll
                for (int j = 0; j < 4; ++j) { const f32x4 g = *(const f32x4*)(lng + lane * 4 + 256 * j), bb = *(const f32x4*)(lnb + lane * 4 + 256 * j);
                    v[q][j] = v[q][j] * rstd * g + bb; *(f32x4*)(dst + lane * 4 + 256 * j) = (ctxalpha && !lat[q]) ? v[q][j] * DN_ALPHA : v[q][j]; }
            }
            if (MODE == 0 && ctxalpha && !lat[q]) { float* dst = dstctx + ro[q];
#pragma unroll
                for (int j = 0; j < 4; ++j) *(f32x4*)(dst + lane * 4 + 256 * j) = v[q][j] * DN_ALPHA; }
            if (wantxn) {
                float s = 0.f;
#pragma unroll
                for (int j = 0; j < 4; ++j) s += (v[q][j][0] + v[q][j][1]) + (v[q][j][2] + v[q][j][3]);
                const float mean = wave_sum(s) * (1.0f / DM); float qq = 0.f;
#pragma unroll
                for (int j = 0; j < 4; ++j) { v[q][j] = v[q][j] - mean; qq += (v[q][j][0] * v[q][j][0] + v[q][j][1] * v[q][j][1]) + (v[q][j][2] * v[q][j][2] + v[q][j][3] * v[q][j][3]); }
                const float rstd = 1.0f / sqrtf(wave_sum(qq) * (1.0f / DM) + LN_EPS);
                const float* sh = modsh + (size_t)bsrc[q] * MODW;
                bf16_t* xo = XN + (size_t)r * DM;
#pragma unroll
                for (int j = 0; j < 4; ++j) { const f32x4 shv = *(const f32x4*)(sh + lane * 4 + 256 * j), scv = *(const f32x4*)(sh + 1024 + lane * 4 + 256 * j);
                    const f32x4 o = v[q][j] * rstd * (scv + 1.0f) + shv; u32x2 w; w.x = pk2(o[0], o[1]); w.y = pk2(o[2], o[3]);
                    *(u32x2*)(xo + lane * 4 + 256 * j) = w; }
            }
        }
    }
}

#ifndef PROBE_K
#define PROBE_K -1
#endif
#define SUBSTAMP(k, wsp, cond) do { if (PROBE_K == (k) && (cond) && blockIdx.x == 0 && threadIdx.x == 0) { const unsigned long long t1_ = __builtin_amdgcn_s_memrealtime(); const unsigned long long d_ = (t1_ - *(volatile unsigned long long*)((wsp) + 255 * MiB + 8)) * 8; while (__builtin_amdgcn_s_memrealtime() - t1_ < d_) __builtin_amdgcn_s_sleep(8); } } while (0)
#define BSTAMP(k, wsp, blk, slot, cond) do { if (PROBE_K == (k) && (cond) && blockIdx.x == (blk) && threadIdx.x == 0) { const unsigned long long t1_ = __builtin_amdgcn_s_memrealtime(); const unsigned long long d_ = (t1_ - *(volatile unsigned long long*)((wsp) + 255 * MiB + (slot))) * 8; while (__builtin_amdgcn_s_memrealtime() - t1_ < d_) __builtin_amdgcn_s_sleep(8); } } while (0)
#define BSTART(wsp, blk, slot, cond) do { if (PROBE_K >= 30 && (cond) && blockIdx.x == (blk) && threadIdx.x == 0) *(volatile unsigned long long*)((wsp) + 255 * MiB + (slot)) = __builtin_amdgcn_s_memrealtime(); } while (0)
__device__ __forceinline__ void gmlp_item(int ci, bf16_t* P, const float* ln_g, const float* ln_b, const float* w_s, const float* b_s, unsigned char* lds, int tid, int lane, int wave) {
    bf16_t* tile = (bf16_t*)lds;
    bf16_t* vT = (bf16_t*)(lds + 67584);
    float* st = (float*)(lds + 137216);
    const int r0 = ci * 128, lr = lane & 15, lq = lane >> 4;
    u32x4 uu[8];
    { u32x4 vv[8];
#pragma unroll
      for (int k = 0; k < 8; ++k) { const int p = tid + NTHR * k, row = p >> 5, cp = p & 31; const bf16_t* src = P + (size_t)(r0 + row) * PP + cp * 8;
          vv[k] = *(const u32x4*)(src + PC_GV); uu[k] = *(const u32x4*)(src + PC_U); }
#pragma unroll
      for (int k = 0; k < 8; ++k) { const int p = tid + NTHR * k, row = p >> 5, cp = p & 31; *(u32x4*)(tile + row * 264 + cp * 8) = vv[k]; } }
    f32x4 aw[4][8];
#pragma unroll
    for (int g = 0; g < 4; ++g)
#pragma unroll
        for (int kk = 0; kk < 4; ++kk) { const float* wp = w_s + (size_t)(g * 128 + wave * 16 + lr) * 128 + kk * 32 + lq * 8;
            aw[g][2 * kk] = *(const f32x4*)wp; aw[g][2 * kk + 1] = *(const f32x4*)(wp + 4); }
    float bsv[4][4];
#pragma unroll
    for (int g = 0; g < 4; ++g)
#pragma unroll
        for (int jx = 0; jx < 4; ++jx) bsv[g][jx] = b_s[g * 128 + wave * 16 + lq * 4 + jx];
    __syncthreads();
    for (int t4 = 0; t4 < 4; ++t4) { float x[4][4], mean[4];
#pragma unroll
        for (int q = 0; q < 4; ++q) { const int tk = wave * 16 + t4 * 4 + q; const u32x2 w = *(const u32x2*)(tile + tk * 264 + lane * 4);
            x[q][0] = gelu_f(bf2f(w.x & 0xffffu)); x[q][1] = gelu_f(bf2f(w.x >> 16)); x[q][2] = gelu_f(bf2f(w.y & 0xffffu)); x[q][3] = gelu_f(bf2f(w.y >> 16));
            mean[q] = (x[q][0] + x[q][1]) + (x[q][2] + x[q][3]); }
#pragma unroll
        for (int o = 1; o < 64; o <<= 1)
#pragma unroll
            for (int q = 0; q < 4; ++q) mean[q] += __shfl_xor(mean[q], o);
        float var[4];
#pragma unroll
        for (int q = 0; q < 4; ++q) { mean[q] *= (1.0f / 256.0f); const float d0 = x[q][0] - mean[q], d1 = x[q][1] - mean[q], d2 = x[q][2] - mean[q], d3 = x[q][3] - mean[q]; var[q] = (d0 * d0 + d1 * d1) + (d2 * d2 + d3 * d3); }
#pragma unroll
        for (int o = 1; o < 64; o <<= 1)
#pragma unroll
            for (int q = 0; q < 4; ++q) var[q] += __shfl_xor(var[q], o);
        if (lane == 0) {
#pragma unroll
            for (int q = 0; q < 4; ++q) { const int tk = wave * 16 + t4 * 4 + q; st[tk * 2] = mean[q]; st[tk * 2 + 1] = 1.0f / sqrtf(var[q] * (1.0f / 256.0f) + LN_EPS); } } }
    __syncthreads();
    for (int k = 0; k < 32; ++k) { const int idx = tid + NTHR * k, sx = idx & 127, c = (idx >> 7) * 2;
        const unsigned w = *(const unsigned*)(tile + sx * 264 + c);
        const float mean = st[2 * sx], rstd = st[2 * sx + 1];
        const float y0 = (gelu_f(bf2f(w & 0xffffu)) - mean) * rstd * ln_g[c] + ln_b[c];
        const float y1 = (gelu_f(bf2f(w >> 16)) - mean) * rstd * ln_g[c + 1] + ln_b[c + 1];
        vT[c * 136 + sx] = (bf16_t)f2bf(y0); vT[(c + 1) * 136 + sx] = (bf16_t)f2bf(y1); }
    __syncthreads();
#pragma unroll
    for (int k = 0; k < 8; ++k) { const int p = tid + NTHR * k, row = p >> 5, cp = p & 31; *(u32x4*)(tile + row * 264 + cp * 8) = uu[k]; }
    f32x4 acc[4][4];
#pragma unroll
    for (int g = 0; g < 4; ++g) {
        bf16x8 Af[4];
#pragma unroll
        for (int kk = 0; kk < 4; ++kk) { const f32x4 a0 = aw[g][2 * kk], a1 = aw[g][2 * kk + 1];
            u32x4 w; w.x = pk2(a0[0], a0[1]); w.y = pk2(a0[2], a0[3]); w.z = pk2(a1[0], a1[1]); w.w = pk2(a1[2], a1[3]); Af[kk] = __builtin_bit_cast(bf16x8, w); }
#pragma unroll
        for (int nt = 0; nt < 4; ++nt) { acc[g][nt] = (f32x4){0.f, 0.f, 0.f, 0.f};
#pragma unroll
            for (int kk = 0; kk < 4; ++kk) { const bf16x8 bfr = *(const bf16x8*)(vT + (g * 64 + 16 * nt + lr) * 136 + kk * 32 + lq * 8);
                acc[g][nt] = __builtin_amdgcn_mfma_f32_16x16x32_bf16(Af[kk], bfr, acc[g][nt], 0, 0, 0); } } }
    __syncthreads();
#pragma unroll
    for (int g = 0; g < 4; ++g)
#pragma unroll
        for (int jx = 0; jx < 4; ++jx) { const int t = wave * 16 + lq * 4 + jx;
#pragma unroll
            for (int nt = 0; nt < 4; ++nt) { bf16_t* up = tile + t * 264 + g * 64 + 16 * nt + lr;
                *up = (bf16_t)f2bf(gelu_f(bf2f(*up)) * (acc[g][nt][jx] + bsv[g][jx])); } }
    __syncthreads();
#pragma unroll
    for (int k = 0; k < 8; ++k) { const int p = tid + NTHR * k, row = p >> 5, cp = p & 31; *(u32x4*)(P + (size_t)(r0 + row) * PP + PC_U + cp * 8) = *(const u32x4*)(tile + row * 264 + cp * 8); }
    __syncthreads();
}

constexpr float ATT_C2 = 0.125f * 1.4426950408889634f;
__device__ __forceinline__ void attn_prep_item(int item, bf16_t* P, const float* q_g, const float* k_g, int lane, int wave) {
    const int hd = lane >> 3, j = lane & 7; const bool isq = hd < 6;
    const int col = isq ? PC_AQ + hd * 64 + j * 8 : PC_AK + (hd - 6) * 64 + j * 8;
    const float* gp = (isq ? q_g : k_g) + j * 8;
    float gam[8];
#pragma unroll
    for (int e = 0; e < 8; ++e) gam[e] = gp[e];
    for (int rr = 0; rr < 8; ++rr) {
        const int r = item * 64 + wave * 8 + rr, b = r / ROWB, t = r - b * ROWB; const bool lat = t < SEQL;
        bf16_t* p = P + (size_t)r * PP + col;
        float x[8]; unpack8(*(const u32x4*)p, x);
        float ss = 0.f;
#pragma unroll
        for (int e = 0; e < 8; ++e) ss += x[e] * x[e];
        ss += __shfl_xor(ss, 1); ss += __shfl_xor(ss, 2); ss += __shfl_xor(ss, 4);
        const float rs = 1.0f / sqrtf(ss * (1.0f / 64.0f) + LN_EPS);
#pragma unroll
        for (int e = 0; e < 8; ++e) x[e] = x[e] * rs * gam[e];
        if (lat) {
            const float pos = (float)((j >> 2) ? (t & 63) : (t >> 6)); const bool x2lane = (j & 2) != 0;
#pragma unroll
            for (int e = 0; e < 8; ++e) { const int f = (j & 1) * 8 + e;
                const float inv = exp2f(-(float)f * (13.287712379549449f / 16.0f)), ang = pos * inv, rev = ang * 0.15915494309189535f;
                const float cs = __builtin_amdgcn_cosf(rev), sn = __builtin_amdgcn_sinf(rev);
                const float other = __shfl_xor(x[e], 2);
                x[e] = x[e] * cs + (x2lane ? other : -other) * sn; }
        }
        if (isq) {
#pragma unroll
            for (int e = 0; e < 8; ++e) x[e] *= ATT_C2;
        }
        *(u32x4*)p = pack8(x);
    }
}

__device__ __forceinline__ float dpp_xor1(float v) { return __builtin_bit_cast(float, __builtin_amdgcn_update_dpp(0, __builtin_bit_cast(int, v), 0xB1, 0xF, 0xF, true)); }
__device__ __forceinline__ void dn_chunk_item(int ck, int h, const bf16_t* P, const float* AB, const float* conv_w, const float* a_log, const float* dt_bias,
                                              unsigned char* ws, unsigned char* lds, int tid_in, int lane_in, bool probe) {
    int tid = tid_in; asm volatile("" : "+v"(tid));
    const int lane = tid & 63, wave = __builtin_amdgcn_readfirstlane(tid >> 6);
    float* raw = (float*)lds;
    float* Lp = (float*)lds;
    bf16_t* qb = (bf16_t*)(lds + 32768); bf16_t* kb = (bf16_t*)(lds + 41984);
    float* qkv = (float*)(lds + 52224);
    float* KKs = (float*)(lds + 102144);
    float* QKs = (float*)(lds + 118784);
    float* gcs = (float*)(lds + 135424);
    const int r0 = ck * 64, b = r0 / ROWB, t0 = r0 - b * ROWB;
    const int seg_lo = b * ROWB + (t0 < SEQL ? 0 : SEQL), seg_hi = b * ROWB + (t0 < SEQL ? SEQL : ROWB);
    float cw[3][5];
#pragma unroll
    for (int m = 0; m < 3; ++m)
#pragma unroll
        for (int jj = 0; jj < 5; ++jj) cw[m][jj] = conv_w[jj * 1152 + m * 384 + h * 64 + (tid & 63)];
    for (int pc = tid; pc < 1632; pc += NTHR) { const int m = pc / 544, rem = pc - m * 544, rr = rem >> 3, ch = rem & 7, row = r0 - 2 + rr;
        float f[8];
#pragma unroll
        for (int e = 0; e < 8; ++e) f[e] = 0.f;
        if (row >= seg_lo && row < seg_hi) unpack8(*(const u32x4*)(P + (size_t)row * PP + PC_DQ + m * 384 + h * 64 + ch * 8), f);
        float* d = raw + (m * 68 + rr) * 64 + ch * 8;
        *(f32x4*)d = (f32x4){f[0], f[1], f[2], f[3]}; *(f32x4*)(d + 4) = (f32x4){f[4], f[5], f[6], f[7]}; }
    __syncthreads();
#pragma unroll
    for (int k = 0; k < 24; ++k) { const int m = k >> 3, i = (tid >> 6) + 8 * (k & 7), d = tid & 63; float s = 0.f;
#pragma unroll
        for (int jj = 0; jj < 5; ++jj) s += cw[m][jj] * raw[(m * 68 + i + jj) * 64 + d];
        qkv[(m * 64 + i) * 65 + d] = silu_f(s); }
    __syncthreads();
    { const int row = tid >> 2, part = tid & 3; float* p = qkv + row * 65 + part * 16; float ss = 0.f;
        float x[16];
#pragma unroll
        for (int e = 0; e < 16; ++e) { x[e] = p[e]; ss += x[e] * x[e]; }
        ss += __shfl_xor(ss, 1); ss += __shfl_xor(ss, 2);
        const float scl = (1.0f / sqrtf(ss + LN_EPS)) * (row < 64 ? 0.125f : 1.0f);
#pragma unroll
        for (int e = 0; e < 16; ++e) { x[e] *= scl; p[e] = x[e]; }
        bf16_t* bp = (row < 64 ? qb : kb) + (row & 63) * 72 + part * 16;
        u32x4 w0, w1; w0.x = pk2(x[0], x[1]); w0.y = pk2(x[2], x[3]); w0.z = pk2(x[4], x[5]); w0.w = pk2(x[6], x[7]);
        w1.x = pk2(x[8], x[9]); w1.y = pk2(x[10], x[11]); w1.z = pk2(x[12], x[13]); w1.w = pk2(x[14], x[15]);
        *(u32x4*)bp = w0; *(u32x4*)(bp + 8) = w1; }
    __syncthreads();
    unsigned char* shp = ws + WS_DNSH + (size_t)(ck * 6 + h) * 16384;
    { const int rw = tid >> 3, c0 = (tid & 7) * 8; float f[8];
#pragma unroll
        for (int e = 0; e < 8; ++e) f[e] = qkv[rw * 65 + c0 + e];
        *(u32x4*)(shp + (size_t)(rw * 64 + c0) * 2) = pack8(f);
#pragma unroll
        for (int e = 0; e < 8; ++e) f[e] = qkv[(64 + c0 + e) * 65 + rw];
        *(u32x4*)(shp + 8192 + (size_t)(rw * 64 + c0) * 2) = pack8(f); }
    SUBSTAMP(31, ws, probe);
    { const int mat = wave >> 2, mt = wave & 3, lr = lane & 15, lq = lane >> 4;
        const bf16_t* Ab = (mat ? qb : kb) + (16 * mt + lr) * 72 + lq * 8;
        const bf16x8 a0 = *(const bf16x8*)Ab, a1 = *(const bf16x8*)(Ab + 32);
        float* Op = (mat ? QKs : KKs) + (16 * mt + lq * 4) * 65 + lr;
#pragma unroll
        for (int nt = 0; nt < 4; ++nt) { const bf16_t* Bb = kb + (16 * nt + lr) * 72 + lq * 8;
            f32x4 acc = (f32x4){0.f, 0.f, 0.f, 0.f};
            acc = __builtin_amdgcn_mfma_f32_16x16x32_bf16(a0, *(const bf16x8*)Bb, acc, 0, 0, 0);
            acc = __builtin_amdgcn_mfma_f32_16x16x32_bf16(a1, *(const bf16x8*)(Bb + 32), acc, 0, 0, 0);
#pragma unroll
            for (int jx = 0; jx < 4; ++jx) Op[jx * 65 + 16 * nt] = acc[jx]; } }
    const int dir = tid >> 8, lt = tid & 255;
    if (lt < 64) { const int i = lt, tok = dir ? 63 - i : i; const float* ab = AB + (size_t)(r0 + tok) * 24;
        const float x = ab[dir * 6 + h] + dt_bias[dir * 6 + h];
        const float sp = fmaxf(x, 0.f) + log1pf(expf(-fabsf(x)));
        float g = -expf(a_log[dir * 6 + h]) * sp;
        const float beta = 1.0f / (1.0f + expf(-ab[12 + dir * 6 + h]));
#pragma unroll
        for (int o = 1; o < 64; o <<= 1) { const float tv = __shfl_up(g, o); if (lane >= o) g += tv; }
        gcs[dir * 64 + i] = g; gcs[128 + dir * 64 + i] = beta; gcs[256 + dir * 64 + i] = expf(g); }
    __syncthreads();
    const float* gc = gcs + dir * 64; const float* bt = gcs + 128 + dir * 64; const float* eg = gcs + 256 + dir * 64;
    const int itd = (ck * 6 + h) * 2 + dir;
    unsigned char* pd = ws + WS_DNPD + (size_t)itd * 24576;
    { float* Ld = Lp + dir * 4096;
#pragma unroll 4
        for (int k = 0; k < 16; ++k) { const int e = lt + 256 * k, i = e >> 6, jx = e & 63, ti = dir ? 63 - i : i, tj = dir ? 63 - jx : jx;
            Ld[i * 64 + (jx & 1) * 32 + (jx >> 1)] = (i > jx) ? bt[i] * KKs[ti * 65 + tj] * expf(gc[i] - gc[jx]) : 0.f; }
        const int i = lt >> 2, j0 = (lt & 3) * 16, ti = dir ? 63 - i : i;
        bf16_t* ip = (bf16_t*)(pd + 16384) + i * 64 + j0;
#pragma unroll
        for (int q8 = 0; q8 < 2; ++q8) { float f[8];
#pragma unroll
            for (int e = 0; e < 8; ++e) { const int jx = j0 + q8 * 8 + e, tj = dir ? 63 - jx : jx; f[e] = (i >= jx) ? QKs[ti * 65 + tj] * expf(gc[i] - gc[jx]) : 0.f; }
            *(u32x4*)(ip + q8 * 8) = pack8(f); }
        float* vec = (float*)(ws + WS_DNVEC) + (size_t)itd * 192;
        if (lt < 64) { vec[lt] = eg[lt]; vec[64 + lt] = expf(gc[63] - gc[lt]); if (lt == 0) vec[128] = eg[63]; } }
    __syncthreads();
    SUBSTAMP(32, ws, probe);
    {
        const int c = lt >> 1, par = lt & 1, cc = c & 63; const bool isv = c < 64;
        const float* rp = qkv + (isv ? 128 : 64) * 65 + cc;
        const float* Lrow = Lp + dir * 4096 + par * 32;
        float sp[32];
#pragma unroll
        for (int m = 0; m < 32; ++m) sp[m] = 0.f;
#pragma unroll
        for (int i = 0; i < 64; ++i) { const int ti = dir ? 63 - i : i;
            float rhs = rp[ti * 65] * bt[i]; if (!isv) rhs *= eg[i];
            float acc0 = 0.f, acc1 = 0.f;
#pragma unroll
            for (int jj = 0; jj < (i + 1) / 2; ++jj) { if (jj & 1) acc1 += Lrow[i * 64 + jj] * sp[jj]; else acc0 += Lrow[i * 64 + jj] * sp[jj]; }
            float acc = acc0 + acc1; acc += dpp_xor1(acc);
            float si = rhs - acc;
            if ((i & 3) == 3) asm volatile("" : "+v"(si) :: "memory"); else asm volatile("" : "+v"(si));
            sp[i >> 1] = ((i & 1) == par) ? si : sp[i >> 1]; }
        if (isv) { unsigned dw[16];
#pragma unroll
            for (int q = 0; q < 16; ++q) { float lo = sp[q], hi = sp[16 + q]; asm volatile("" : "+v"(lo), "+v"(hi));
                const float mine = par ? hi : lo, send = par ? lo : hi, recv = dpp_xor1(send);
                dw[q] = par ? pk2(recv, mine) : pk2(mine, recv); }
            bf16_t* uT = (bf16_t*)pd + cc * 64 + par * 32;
#pragma unroll
            for (int q4 = 0; q4 < 4; ++q4) { u32x4 w; w.x = dw[q4 * 4]; w.y = dw[q4 * 4 + 1]; w.z = dw[q4 * 4 + 2]; w.w = dw[q4 * 4 + 3]; *(u32x4*)(uT + q4 * 8) = w; } }
        else { bf16_t* wp = (bf16_t*)(pd + 8192) + par * 64 + cc;
#pragma unroll
            for (int m = 0; m < 32; ++m) wp[m * 128] = (bf16_t)f2bf(sp[m]); }
    }
    __syncthreads();
    SUBSTAMP(33, ws, probe);
}

struct ScanIn { bf16x8 Aw[2], Aq[2], Ai[2], Ak[2]; u32x2 U[2]; f32x4 egc4, ekd4; float egl; int r0; };
__device__ __forceinline__ void scan_load(ScanIn& in, int s, int b, int h, int dir, const unsigned char* ws, int rowA, int tokA, int c4, int ni0, int lr, int lq) {
    const int ckl = dir ? 67 - s : (s < 4 ? 64 + s : s - 4);
    const int ck = b * 68 + ckl, it = ck * 6 + h, itd = it * 2 + dir;
    const unsigned char* shp = ws + WS_DNSH + (size_t)it * 16384;
    const unsigned char* pd = ws + WS_DNPD + (size_t)itd * 24576;
    const float* vec = (const float*)(ws + WS_DNVEC) + (size_t)itd * 192;
    in.r0 = ck * 64;
#pragma unroll
    for (int kk = 0; kk < 2; ++kk) {
        in.Aw[kk] = *(const bf16x8*)(pd + 8192 + (size_t)(rowA * 64 + kk * 32 + lq * 8) * 2);
        in.Aq[kk] = *(const bf16x8*)(shp + (size_t)(tokA * 64 + kk * 32 + lq * 8) * 2);
        in.Ai[kk] = *(const bf16x8*)(pd + 16384 + (size_t)(rowA * 64 + kk * 32 + lq * 8) * 2);
        in.Ak[kk] = *(const bf16x8*)(shp + 8192 + (size_t)(rowA * 64 + kk * 32 + lq * 8) * 2); }
#pragma unroll
    for (int n = 0; n < 2; ++n) in.U[n] = *(const u32x2*)(pd + (size_t)((16 * (ni0 + n) + lr) * 64 + c4) * 2);
    in.egc4 = *(const f32x4*)(vec + c4); in.ekd4 = *(const f32x4*)(vec + 64 + c4); in.egl = vec[128];
}
__device__ __forceinline__ void scan_step(const ScanIn& in, f32x4 (&Sacc)[2], int& cur, bf16_t* ST, bf16_t* vnT, bf16_t* vnT2, bf16_t* Ot, bf16_t* P, int ocol, int prev_r0,
                                          int dir, int tid, int ni0, int lr, int lq, int c4) {
#define SCAN_BAR() do { asm volatile("s_waitcnt lgkmcnt(0)" ::: "memory"); __builtin_amdgcn_s_barrier(); asm volatile("" ::: "memory"); } while (0)
    bf16x8 BS[2][2];
#pragma unroll
    for (int n = 0; n < 2; ++n)
#pragma unroll
        for (int kk = 0; kk < 2; ++kk) BS[n][kk] = *(const bf16x8*)(ST + cur * 4608 + (16 * (ni0 + n) + lr) * 72 + kk * 32 + lq * 8);
    if (prev_r0 >= 0) { const int row = tid >> 3, pc = tid & 7; *(u32x4*)(P + (size_t)(prev_r0 + row) * PP + ocol + pc * 8) = *(const u32x4*)(Ot + row * 72 + pc * 8); }
#pragma unroll
    for (int n = 0; n < 2; ++n) { f32x4 acc = (f32x4){0.f, 0.f, 0.f, 0.f};
        acc = __builtin_amdgcn_mfma_f32_16x16x32_bf16(in.Aw[0], BS[n][0], acc, 0, 0, 0); acc = __builtin_amdgcn_mfma_f32_16x16x32_bf16(in.Aw[1], BS[n][1], acc, 0, 0, 0);
        const float v0 = bf2f(in.U[n].x & 0xffffu) - acc[0], v1 = bf2f(in.U[n].x >> 16) - acc[1], v2 = bf2f(in.U[n].y & 0xffffu) - acc[2], v3 = bf2f(in.U[n].y >> 16) - acc[3];
        const int vrow = (16 * (ni0 + n) + lr) * 72;
        u32x2 w; w.x = pk2(v0, v1); w.y = pk2(v2, v3); *(u32x2*)(vnT + vrow + c4) = w;
        const float s0 = v0 * in.ekd4[0], s1 = v1 * in.ekd4[1], s2 = v2 * in.ekd4[2], s3 = v3 * in.ekd4[3];
        if (dir == 0) { w.x = pk2(s0, s1); w.y = pk2(s2, s3); *(u32x2*)(vnT2 + vrow + c4) = w; }
        else { w.x = pk2(s3, s2); w.y = pk2(s1, s0); *(u32x2*)(vnT2 + vrow + 60 - c4) = w; } }
    SCAN_BAR();
#pragma unroll
    for (int n = 0; n < 2; ++n) { f32x4 acc = (f32x4){0.f, 0.f, 0.f, 0.f};
        acc = __builtin_amdgcn_mfma_f32_16x16x32_bf16(in.Aq[0], BS[n][0], acc, 0, 0, 0); acc = __builtin_amdgcn_mfma_f32_16x16x32_bf16(in.Aq[1], BS[n][1], acc, 0, 0, 0);
        acc = acc * in.egc4;
        const int vrow = (16 * (ni0 + n) + lr) * 72;
        const bf16x8 bv0 = *(const bf16x8*)(vnT + vrow + lq * 8), bv1 = *(const bf16x8*)(vnT + vrow + 32 + lq * 8);
        acc = __builtin_amdgcn_mfma_f32_16x16x32_bf16(in.Ai[0], bv0, acc, 0, 0, 0); acc = __builtin_amdgcn_mfma_f32_16x16x32_bf16(in.Ai[1], bv1, acc, 0, 0, 0);
#pragma unroll
        for (int jx = 0; jx < 4; ++jx) { const int c = c4 + jx, tok = dir ? 63 - c : c; Ot[tok * 72 + 16 * (ni0 + n) + lr] = (bf16_t)f2bf(acc[jx]); }
        const bf16x8 b20 = *(const bf16x8*)(vnT2 + vrow + lq * 8), b21 = *(const bf16x8*)(vnT2 + vrow + 32 + lq * 8);
        f32x4 sa = Sacc[n] * in.egl;
        sa = __builtin_amdgcn_mfma_f32_16x16x32_bf16(in.Ak[0], b20, sa, 0, 0, 0); sa = __builtin_amdgcn_mfma_f32_16x16x32_bf16(in.Ak[1], b21, sa, 0, 0, 0);
        Sacc[n] = sa;
        u32x2 w; w.x = pk2(sa[0], sa[1]); w.y = pk2(sa[2], sa[3]); *(u32x2*)(ST + (cur ^ 1) * 4608 + vrow + c4) = w; }
    cur ^= 1;
    SCAN_BAR();
}
__device__ __forceinline__ void dn_scan_unit(int b, int h, int dir, bf16_t* P, const unsigned char* ws, unsigned char* lds, int tid, int lane, int wave) {
    bf16_t* ST = (bf16_t*)lds;
    bf16_t* vnT = ST + 2 * 4608;
    bf16_t* vnT2 = vnT + 4608;
    bf16_t* Ot = vnT2 + 4608;
    for (int i = tid; i < 5 * 4608 / 2; i += NTHR) ((unsigned*)lds)[i] = 0u;
    __syncthreads();
    const int mi = wave >> 1, ni0 = (wave & 1) * 2, lr = lane & 15, lq = lane >> 4;
    f32x4 Sacc[2]; Sacc[0] = (f32x4){0.f, 0.f, 0.f, 0.f}; Sacc[1] = Sacc[0];
    int cur = 0;
    const int rowA = 16 * mi + lr, tokA = dir ? 63 - rowA : rowA, c4 = 16 * mi + lq * 4, ocol = (dir ? PC_DK : PC_DQ) + h * 64;
    ScanIn sA, sB, sC, sD;
#define SCAN_LD(SET, sidx) scan_load(SET, (sidx) < 68 ? (sidx) : 67, b, h, dir, ws, rowA, tokA, c4, ni0, lr, lq)
    SCAN_LD(sA, 0); SCAN_LD(sB, 1); SCAN_LD(sC, 2);
    int prev_r0 = -1;
    for (int s = 0; s < 68; s += 4) {
        SCAN_LD(sD, s + 3); scan_step(sA, Sacc, cur, ST, vnT, vnT2, Ot, P, ocol, prev_r0, dir, tid, ni0, lr, lq, c4); prev_r0 = sA.r0;
        SCAN_LD(sA, s + 4); scan_step(sB, Sacc, cur, ST, vnT, vnT2, Ot, P, ocol, prev_r0, dir, tid, ni0, lr, lq, c4); prev_r0 = sB.r0;
        SCAN_LD(sB, s + 5); scan_step(sC, Sacc, cur, ST, vnT, vnT2, Ot, P, ocol, prev_r0, dir, tid, ni0, lr, lq, c4); prev_r0 = sC.r0;
        SCAN_LD(sC, s + 6); scan_step(sD, Sacc, cur, ST, vnT, vnT2, Ot, P, ocol, prev_r0, dir, tid, ni0, lr, lq, c4); prev_r0 = sD.r0;
    }
    { const int row = tid >> 3, pc = tid & 7; *(u32x4*)(P + (size_t)(prev_r0 + row) * PP + ocol + pc * 8) = *(const u32x4*)(Ot + row * 72 + pc * 8); }
    __syncthreads();
#undef SCAN_LD
#undef SCAN_BAR
}

__device__ __forceinline__ void dn_gate_rows(bf16_t* P, const float* norm_g, int lane, int wave, int G) {
    const int gw = blockIdx.x * NWV + wave, NGW = G * NWV; const float ng = norm_g[lane];
    for (int r = gw; r < NROW; r += NGW) { bf16_t* pr = P + (size_t)r * PP;
#pragma unroll
        for (int h = 0; h < 6; ++h) { const float o = bf2f(pr[PC_DQ + h * 64 + lane]) + bf2f(pr[PC_DK + h * 64 + lane]);
            const float ss = wave_sum(o * o); const float z = bf2f(pr[PC_Z + h * 64 + lane]);
            pr[PC_Z + h * 64 + lane] = (bf16_t)f2bf(o * (1.0f / sqrtf(ss * (1.0f / 64.0f) + LN_EPS)) * ng * silu_f(z)); } }
}

#ifndef EN_G1
#define EN_G1 1
#endif
#ifndef EN_G2
#define EN_G2 1
#endif
#ifndef EN_G3
#define EN_G3 1
#endif
#ifndef EN_G4
#define EN_G4 1
#endif
#ifndef EN_CTX
#define EN_CTX 1
#endif
#ifndef EN_PRO
#define EN_PRO 1
#endif
#ifndef EN_GEMM
#define EN_GEMM 1
#endif
#ifndef EN_GMLP
#define EN_GMLP 1
#endif
#ifndef EN_DNC
#define EN_DNC 1
#endif
#ifndef EN_PREP
#define EN_PREP 1
#endif
#ifndef EN_SCAN
#define EN_SCAN 1
#endif
#ifndef EN_ATTN
#define EN_ATTN 1
#endif
#ifndef EN_GATE
#define EN_GATE 1
#endif
#ifndef EN_LN
#define EN_LN 1
#endif
constexpr int LDS_BYTES = 147456;
#ifndef PROBE_K
#define PROBE_K -1
#endif
#ifndef PROBE_MULT
#define PROBE_MULT 1
#endif
#define STAMP(k) do { if (PROBE_K == (k) && blockIdx.x == 0 && threadIdx.x == 0) { const unsigned long long t1_ = __builtin_amdgcn_s_memrealtime(); const unsigned long long d_ = (t1_ - *(volatile unsigned long long*)(a.ws + 255 * MiB)) * PROBE_MULT; while (__builtin_amdgcn_s_memrealtime() - t1_ < d_) __builtin_amdgcn_s_sleep(8); } } while (0)
#define FRESH() do { tid = threadIdx.x; asm volatile("" : "+v"(tid)); lane = tid & 63; wave = __builtin_amdgcn_readfirstlane(tid >> 6); } while (0)
#define FRESHL() do { asm volatile("" : "+s"(l)); wb = ws + WS_W + (size_t)l * W_LAYER; mv = modv + (size_t)l * 5 * MODW; xlat = l == 0 ? a.in[0] : a.out; xctx = l == 0 ? a.in[2] : Xctx; } while (0)
template <int LYR> __device__ __forceinline__ void layer_fwd(const Args& a, unsigned char* lds, cg::grid_group& grid) {
    int tid = threadIdx.x, lane = tid & 63, wave = __builtin_amdgcn_readfirstlane(tid >> 6); const int G = gridDim.x;
    unsigned char* ws = a.ws;
    bf16_t* P = (bf16_t*)(ws + WS_P); bf16_t* XN = (bf16_t*)(ws + WS_XN); bf16_t* H = (bf16_t*)(ws + WS_H);
    float* AB = (float*)(ws + WS_AB); float* Xctx = (float*)(ws + WS_XCTX); float* modv = (float*)(ws + WS_MODV);
    PG8_LAS unsigned char* lds3 = (PG8_LAS unsigned char*)lds;
    int l = LYR;
        const unsigned char* wb; const float* mv; const float* xlat; const float* xctx;
        FRESHL();
        { pg8::Gemm g{XN, (const bf16_t*)(wb + W_IN_OFF), NROW, 2816, 1024, 1024, 0, 1024}; pg8::StaticOrder S; S.init(NROW, 2816, G, (int)blockIdx.x);
          pg8::EpiP E{P, AB}; if (EN_GEMM && EN_G1) pg8::gemm_phase<pg8::EpiP, pg8::StaticOrder, true, true>(lds3, g, S, E); }
        grid.sync(); STAMP(2 + 9 * LYR + 0);
        FRESHL();
        if (PROBE_K >= 30 && LYR == 0 && blockIdx.x == 0 && threadIdx.x == 0) *(volatile unsigned long long*)(ws + 255 * MiB + 8) = __builtin_amdgcn_s_memrealtime();
        BSTART(ws, 96, 24, LYR == 0);
        for (int it = blockIdx.x; it < 1632 + 272; it += G) { FRESH();
            BSTAMP(42, ws, 96, 24, LYR == 0 && it == 1632);
            BSTAMP(41, ws, 96, 24, LYR == 0 && it == 1888);
            if (it < 1632) { const int q = it; if (EN_DNC) dn_chunk_item(q / 6, q % 6, P, AB, a.in[14] + (size_t)l * 5 * 1152, a.in[15] + l * 12, a.in[16] + l * 12, ws, lds, tid, lane, LYR == 0 && it == 0); }
            else if (EN_PREP) attn_prep_item(it - 1632, P, a.in[12] + l * 64, a.in[13] + l * 64, lane, wave);
        }
        grid.sync(); STAMP(2 + 9 * LYR + 1);
        FRESHL();
        FRESH();
        BSTART(ws, 0, 16, LYR == 0); BSTART(ws, 48, 32, LYR == 0); BSTART(ws, 255, 40, LYR == 0);
        if (blockIdx.x < 48) { const int u = blockIdx.x; if (EN_SCAN) dn_scan_unit(u / 12, (u % 12) >> 1, u & 1, P, ws, lds, tid, lane, wave); BSTAMP(40, ws, 0, 16, LYR == 0); }
        else {
            const int nat = (l == 0) ? 408 : 384;
            if (EN_GMLP) for (int ci = G - 1 - (int)blockIdx.x; ci < 136; ci += G - 48) { FRESH();
                if (LYR != 0 && (ci % 34) >= 32) continue;
                gmlp_item(ci, P, a.in[8] + l * 256, a.in[9] + l * 256, a.in[10] + (size_t)l * 4 * 128 * 128, a.in[11] + l * 512, lds, tid, lane, wave); }
            FRESH();
            if (EN_ATTN) for (int u = blockIdx.x - 48; u < nat; u += G - 48) {
                const attn_body::bf16* Pb = (const attn_body::bf16*)P;
                if (u < 384) { const int b = u / 96, rem = u - b * 96, hq = rem >> 4, qb = rem & 15; const size_t rb = (size_t)b * ROWB;
                    attn_body::attn_unit<8>(Pb + (rb + qb * 256) * PP + PC_AQ + hq * 64, Pb + rb * PP + PC_AK + (hq / 3) * 64, Pb + rb * PP + PC_AV + (hq / 3) * 64,
                                            (attn_body::bf16*)P + (rb + qb * 256) * PP + PC_AQ + hq * 64, 68, (char*)lds); }
                else { const int v = u - 384, b = v / 6, hq = v - b * 6; const size_t rb = (size_t)b * ROWB + SEQL;
                    attn_body::attn_unit<8>(Pb + rb * PP + PC_AQ + hq * 64, Pb + rb * PP + PC_AK + (hq / 3) * 64, Pb + rb * PP + PC_AV + (hq / 3) * 64,
                                            (attn_body::bf16*)P + rb * PP + PC_AQ + hq * 64, 4, (char*)lds); }
            }
            BSTAMP(43, ws, 48, 32, LYR == 0); BSTAMP(44, ws, 255, 40, LYR == 0);
        }
        grid.sync(); STAMP(2 + 9 * LYR + 2);
        FRESHL();
        FRESH(); if (EN_GATE) dn_gate_rows(P, a.in[17] + l * 64, lane, wave, G);
        grid.sync(); STAMP(2 + 9 * LYR + 3);
        FRESHL();
        { constexpr int MR = NB * SEQL; pg8::Gemm g{P, (const bf16_t*)(wb + W_OUT_OFF), MR, 1024, 1024, PP, 1, 1024}; pg8::StaticOrder S; S.init(MR, 1024, G, (int)blockIdx.x);
          pg8::EpiRes E{xlat, xctx, a.out, Xctx, mv + 2 * 1024, 1}; if (EN_GEMM && EN_G2) pg8::gemm_phase<pg8::EpiRes, pg8::StaticOrder, true, true>(lds3, g, S, E); }
        if (LYR == 0) { pg8::Gemm g{P, (const bf16_t*)(wb + W_OUT_OFF), NROW, 1024, 256, PP, 0, 1024}; pg8::CtxOrder S; S.init(4, 256, G, (int)blockIdx.x);
          pg8::EpiCtxPart E{(float*)(ws + WS_PART), mv + 2 * 1024 + 4 * MODW, 8}; if (EN_GEMM && EN_G2 && EN_CTX) pg8::gemm_phase<pg8::EpiCtxPart, pg8::CtxOrder, true, true>(lds3, g, S, E); }
        grid.sync(); STAMP(2 + 9 * LYR + 4);
        FRESHL();
        FRESH(); if (EN_LN) ln_rows<1>(a.out, Xctx, a.out, Xctx, a.in[18] + l * 1024, a.in[19] + l * 1024, mv + 3 * 1024, XN, true, LYR != 0, LYR == 0, LYR == 0 ? (const float*)(ws + WS_PART) : nullptr, lane, wave, G);
        grid.sync(); STAMP(2 + 9 * LYR + 5);
        FRESHL();
        { constexpr int MR = LYR == 0 ? NROW : NB * SEQL; pg8::Gemm g{XN, (const bf16_t*)(wb + W_UP_OFF), MR, DFF, 1024, 1024, LYR != 0, 1024}; pg8::StaticOrder S; S.init(MR, DFF, G, (int)blockIdx.x);
          pg8::EpiH E{H}; if (EN_GEMM && EN_G3) pg8::gemm_phase<pg8::EpiH, pg8::StaticOrder, true, true>(lds3, g, S, E); }
        grid.sync(); STAMP(2 + 9 * LYR + 6);
        FRESHL();
        { constexpr int MR = NB * SEQL; pg8::Gemm g{H, (const bf16_t*)(wb + W_DN_OFF), MR, 1024, DFF, DFF, LYR == 0, DFF}; pg8::StaticOrder S; S.init(MR, 1024, G, (int)blockIdx.x);
          pg8::EpiRes E{a.out, Xctx, a.out, Xctx, mv + 5 * 1024, 1}; if (EN_GEMM && EN_G4) pg8::gemm_phase<pg8::EpiRes, pg8::StaticOrder, true, true>(lds3, g, S, E); }
        if (LYR == 0) { pg8::Gemm g{H, (const bf16_t*)(wb + W_DN_OFF), NROW, 1024, 1024, DFF, 0, DFF}; pg8::CtxOrder S; S.init(4, 1024, G, (int)blockIdx.x);
          pg8::EpiCtxPart E{(float*)(ws + WS_PART), mv + 5 * 1024 + 4 * MODW, 10}; if (EN_GEMM && EN_G4 && EN_CTX) pg8::gemm_phase<pg8::EpiCtxPart, pg8::CtxOrder, true, true>(lds3, g, S, E); }
        grid.sync(); STAMP(2 + 9 * LYR + 7);
        FRESHL();
        FRESH(); if (EN_LN) ln_rows<1>(a.out, Xctx, a.out, Xctx, a.in[20] + l * 1024, a.in[21] + l * 1024, modv + (size_t)(l + 1) * 5 * MODW, XN, l + 1 < NLAYER, l + 1 == NLAYER, false, LYR == 0 ? (const float*)(ws + WS_PART) : nullptr, lane, wave, G);
        if (l + 1 < NLAYER) grid.sync(); STAMP(2 + 9 * LYR + 8);
}

__global__ void __launch_bounds__(NTHR, 2) mega_fwd(Args a) {
    extern __shared__ __attribute__((aligned(16))) unsigned char lds[];
    cg::grid_group grid = cg::this_grid();
    if (PROBE_K >= 0 && blockIdx.x == 0 && threadIdx.x == 0) *(volatile unsigned long long*)(a.ws + 255 * MiB) = __builtin_amdgcn_s_memrealtime();
    {
        int tid = threadIdx.x, lane = tid & 63, wave = __builtin_amdgcn_readfirstlane(tid >> 6); const int G = gridDim.x;
        unsigned char* ws = a.ws;
        bf16_t* P = (bf16_t*)(ws + WS_P); bf16_t* XN = (bf16_t*)(ws + WS_XN); bf16_t* H = (bf16_t*)(ws + WS_H);
        float* AB = (float*)(ws + WS_AB); float* Xctx = (float*)(ws + WS_XCTX); float* modv = (float*)(ws + WS_MODV);
        PG8_LAS unsigned char* lds3 = (PG8_LAS unsigned char*)lds;
#if EN_PRO
        FRESH(); phase_prologue(a, lds, tid, lane, wave, G);
#endif
        grid.sync(); STAMP(0);
        FRESH(); if (EN_LN) ln_rows<0>(a.in[0], a.in[2], nullptr, Xctx, nullptr, nullptr, modv, XN, true, false, true, nullptr, lane, wave, G);
        grid.sync(); STAMP(1);
    }
    layer_fwd<0>(a, lds, grid);
    layer_fwd<1>(a, lds, grid);
    STAMP(20);
}

extern "C" void kernel_launch(void* const* d_in, const int* in_sizes, int n_in, void* d_out, int out_size, void* d_ws, size_t ws_size, hipStream_t stream) {
    static int grid = 0;
    if (grid == 0) {
        int dev = 0, cus = 0, per_cu = 0;
        hipGetDevice(&dev);
        hipDeviceGetAttribute(&cus, hipDeviceAttributeMultiprocessorCount, dev);
        if (hipFuncSetAttribute((const void*)mega_fwd, hipFuncAttributeMaxDynamicSharedMemorySize, LDS_BYTES) != hipSuccess) fprintf(stderr, "kernel_launch: hipFuncSetAttribute failed\n");
        if (hipOccupancyMaxActiveBlocksPerMultiprocessor(&per_cu, (const void*)mega_fwd, NTHR, LDS_BYTES) != hipSuccess || per_cu < 1) { fprintf(stderr, "kernel_launch: occupancy query says %d\n", per_cu); per_cu = 1; }
        (void)hipGetLastError();
        grid = cus * 1;
        if (n_in != 24 || ws_size < 254 * MiB) fprintf(stderr, "kernel_launch: unexpected n_in %d / ws %zu\n", n_in, ws_size);
    }
    Args a{};
    for (int i = 0; i < 24; ++i) a.in[i] = (const float*)d_in[i];
    a.out = (float*)d_out; a.ws = (unsigned char*)d_ws;
    void* params[] = {&a};
    hipError_t e = hipLaunchCooperativeKernel((const void*)mega_fwd, dim3(grid), dim3(NTHR), params, LDS_BYTES, stream);
    if (e != hipSuccess) fprintf(stderr, "kernel_launch: cooperative launch failed: %s (grid %d)\n", hipGetErrorString(e), grid);
}
```
